# Optimizing an MI355X kernel written in HIP

```python
import math
import jax
import jax.numpy as jnp
from jax import lax
import numpy as np

D_MODEL = 1024
BATCH = 8
SEQ = 2048
DEPTH = 4

GRID_W = 64
CTX_LEN = 256
HEAD_DIM = 64
D_MIX = D_MODEL
GDN_WIDTH = D_MIX // 4
GDN_HEADS = GDN_WIDTH // HEAD_DIM
GDN_CHUNK = 64
SHORT_CONV = 4
LRU_WIDTH = D_MIX // 4
LRU_BLOCKS = 4
LRU_BLOCK_W = LRU_WIDTH // LRU_BLOCKS
LRU_C = 8.0
ATT_WIDTH = D_MIX - GDN_WIDTH - LRU_WIDTH
ATT_Q_HEADS = ATT_WIDTH // HEAD_DIM
ATT_KV_HEADS = 2
ATT_GROUP = ATT_Q_HEADS // ATT_KV_HEADS
ATT_KV_WIDTH = ATT_KV_HEADS * HEAD_DIM
Q_BLOCK = 128
ROPE_THETA = 10000.0
ROPE_AXIS_DIM = HEAD_DIM // 2
GDN_PROJ = 4 * GDN_WIDTH + 4 * GDN_HEADS
LRU_PROJ = 2 * LRU_WIDTH
ATT_PROJ = ATT_WIDTH + 2 * ATT_KV_WIDTH
D_IN_PROJ = GDN_PROJ + LRU_PROJ + ATT_PROJ
MOE_GROUPS = 8
MOE_EXPERTS_PER_GROUP = 8
MOE_EXPERTS = MOE_GROUPS * MOE_EXPERTS_PER_GROUP
MOE_TOP_K = 2
MOE_HIDDEN = 512
MOE_BLOCK = 128
EPS = 1e-6

kernel_name = 'hybrid_prefix_dit_gdn_rglru_gqa_hmoe'


def rms_norm(x, g):
    xf = x.astype(jnp.float32)
    y = xf * lax.rsqrt(jnp.mean(xf * xf, axis=-1, keepdims=True) + EPS)
    return (y * g.astype(jnp.float32)).astype(x.dtype)


def l2_norm(x):
    return x * lax.rsqrt(jnp.sum(x * x, axis=-1, keepdims=True) + EPS)


def modulate(x, g, shift, scale):
    return rms_norm(x, g) * (1 + scale) + shift


def depthwise_conv(x, w, b=None):
    k = w.shape[0]
    lo = (k - 1) // 2
    y = lax.conv_general_dilated(x, w[:, None, :].astype(x.dtype), (1,), [(lo, k - 1 - lo)],
                                 dimension_numbers=('NWC', 'WIO', 'NWC'),
                                 feature_group_count=x.shape[-1])
    if b is not None:
        y = y + b
    return y


def axial_rope_tables(rows):
    row = jnp.repeat(jnp.arange(rows, dtype=jnp.float32), GRID_W)
    col = jnp.tile(jnp.arange(GRID_W, dtype=jnp.float32), rows)
    inv_freq = ROPE_THETA ** (-jnp.arange(0, ROPE_AXIS_DIM, 2, dtype=jnp.float32) / ROPE_AXIS_DIM)
    ang = jnp.concatenate([row[:, None] * inv_freq, col[:, None] * inv_freq], axis=-1)
    return jnp.cos(ang), jnp.sin(ang)


def rotate_pairs(x, cos, sin):
    x1, x2 = jnp.split(x, 2, axis=-1)
    return jnp.concatenate([x1 * cos - x2 * sin, x1 * sin + x2 * cos], axis=-1)


def apply_axial_rope(x, cos, sin):
    n = ROPE_AXIS_DIM // 2
    cos = cos[:, None, :].astype(x.dtype)
    sin = sin[:, None, :].astype(x.dtype)
    xr = rotate_pairs(x[..., :ROPE_AXIS_DIM], cos[..., :n], sin[..., :n])
    xc = rotate_pairs(x[..., ROPE_AXIS_DIM:], cos[..., n:], sin[..., n:])
    return jnp.concatenate([xr, xc], axis=-1)


def gated_delta_chunked(q, k, v, beta, g, state):
    b, t, h, dk = q.shape
    dv = v.shape[-1]
    n = t // GDN_CHUNK

    def chunks(a):
        a = a.reshape((b, n, GDN_CHUNK, h) + a.shape[3:])
        return jnp.moveaxis(a, (1, 3), (0, 2))

    qc, kc, vc, bc, gc = (chunks(a) for a in (q, k, v, beta, g))
    gcum = jnp.cumsum(gc, axis=-1)
    lower = jnp.tril(jnp.ones((GDN_CHUNK, GDN_CHUNK), dtype=bool))
    strict = jnp.tril(jnp.ones((GDN_CHUNK, GDN_CHUNK), dtype=bool), k=-1)
    decay = jnp.exp(jnp.where(lower, gcum[..., :, None] - gcum[..., None, :], -jnp.inf))
    kb = kc * bc[..., None]
    a_mat = jnp.where(strict, jnp.einsum('nbhid,nbhjd->nbhij', kb, kc) * decay, 0.0)
    eye = jnp.eye(GDN_CHUNK, dtype=q.dtype)
    rhs = jnp.concatenate([vc * bc[..., None], kb * jnp.exp(gcum)[..., None]], axis=-1)
    sol = lax.linalg.triangular_solve(eye + a_mat, rhs, left_side=True, lower=True)
    u, w = sol[..., :dv], sol[..., dv:]
    qk = jnp.where(lower, jnp.einsum('nbhid,nbhjd->nbhij', qc, kc) * decay, 0.0)

    def step(s, inp):
        q_i, k_i, u_i, w_i, g_i, qk_i = inp
        v_new = u_i - jnp.einsum('bhck,bhkv->bhcv', w_i, s)
        o = (jnp.einsum('bhck,bhkv->bhcv', q_i * jnp.exp(g_i)[..., None], s)
             + jnp.einsum('bhij,bhjv->bhiv', qk_i, v_new))
        g_last = g_i[..., -1:]
        s = (s * jnp.exp(g_last)[..., None]
             + jnp.einsum('bhck,bhcv->bhkv', k_i * jnp.exp(g_last - g_i)[..., None], v_new))
        return s, o

    state, o = lax.scan(step, state, (qc, kc, u, w, gcum, qk))
    o = jnp.moveaxis(o, (0, 2), (1, 3)).reshape(b, t, h, dv)
    return o, state


def gdn_mixer(p_lat, p_ctx, conv_w, a_log, dt_bias, norm_g, need_ctx):
    f32 = jnp.float32

    def prep(p):
        bsz, t, _ = p.shape
        qkv = jax.nn.silu(depthwise_conv(p[..., :3 * GDN_WIDTH], conv_w)).astype(f32)
        qkv = qkv.reshape(bsz, t, 3, GDN_HEADS, HEAD_DIM)
        q = l2_norm(qkv[:, :, 0]) * HEAD_DIM ** -0.5
        k = l2_norm(qkv[:, :, 1])
        v = qkv[:, :, 2]
        gate = p[..., 3 * GDN_WIDTH:4 * GDN_WIDTH]
        ab = p[..., 4 * GDN_WIDTH:].astype(f32).reshape(bsz, t, 2, 2, GDN_HEADS)
        g = -jnp.exp(a_log) * jax.nn.softplus(ab[:, :, 0] + dt_bias)
        beta = jax.nn.sigmoid(ab[:, :, 1])
        return q, k, v, beta, g, gate

    flip = lambda a: jnp.flip(a, axis=1)

    def bidir(q, k, v, beta, g, s0f, s0b):
        of, sf = gated_delta_chunked(q, k, v, beta[:, :, 0], g[:, :, 0], s0f)
        ob, sb = gated_delta_chunked(flip(q), flip(k), flip(v), flip(beta[:, :, 1]), flip(g[:, :, 1]), s0b)
        return of + flip(ob), sf, sb

    def readout(o, gate, dtype):
        bsz, t = o.shape[:2]
        y = rms_norm(o, norm_g).reshape(bsz, t, GDN_WIDTH) * jax.nn.silu(gate.astype(f32))
        return y.astype(dtype)

    qc, kc, vc, bc, gcx, gate_c = prep(p_ctx)
    s0 = jnp.zeros((qc.shape[0], GDN_HEADS, HEAD_DIM, HEAD_DIM), f32)
    oc, sf, sb = bidir(qc, kc, vc, bc, gcx, s0, s0)
    ql, kl, vl, bl, gl, gate_l = prep(p_lat)
    ol, _, _ = bidir(ql, kl, vl, bl, gl, sf, sb)
    out_l = readout(ol, gate_l, p_lat.dtype)
    out_c = readout(oc, gate_c, p_ctx.dtype) if need_ctx else None
    return out_l, out_c


def lru_coefficients(xr, w_r, b_r, w_i, b_i, lam):
    bsz, t, _ = xr.shape
    xb = xr.reshape(bsz, t, LRU_BLOCKS, LRU_BLOCK_W)
    r = jax.nn.sigmoid(jnp.einsum('btnd,nde->btne', xb, w_r).reshape(bsz, t, LRU_WIDTH) + b_r)
    i = jax.nn.sigmoid(jnp.einsum('btnd,nde->btne', xb, w_i).reshape(bsz, t, LRU_WIDTH) + b_i)
    log_a = -LRU_C * r * jax.nn.softplus(-lam)
    return jnp.exp(log_a), jnp.sqrt(-jnp.expm1(2.0 * log_a)) * (i * xr)


def linear_scan(a, bx, h0):
    def combine(e1, e2):
        return e1[0] * e2[0], e2[0] * e1[1] + e2[1]
    a_cum, b_cum = lax.associative_scan(combine, (a, bx), axis=1)
    h = a_cum * h0[:, None, :] + b_cum
    return h, h[:, -1]


def lru_mixer(p_lat, p_ctx, conv_w, conv_b, w_r, b_r, w_i, b_i, lam, need_ctx):
    f32 = jnp.float32

    def branches(p):
        xr = depthwise_conv(p[..., :LRU_WIDTH], conv_w, conv_b).astype(f32)
        y = jax.nn.gelu(p[..., LRU_WIDTH:].astype(f32), approximate=True)
        return xr, y

    def direction(xr, d, h0):
        a, bx = lru_coefficients(xr, w_r[d], b_r[d], w_i[d], b_i[d], lam[d])
        return linear_scan(a, bx, h0)

    flip = lambda a: jnp.flip(a, axis=1)
    xr_c, y_c = branches(p_ctx)
    xr_l, y_l = branches(p_lat)
    h0 = jnp.zeros((xr_c.shape[0], LRU_WIDTH), f32)
    hc_f, s_f = direction(xr_c, 0, h0)
    hc_b, s_b = direction(flip(xr_c), 1, h0)
    hl_f, _ = direction(xr_l, 0, s_f)
    hl_b, _ = direction(flip(xr_l), 1, s_b)
    out_l = ((hl_f + flip(hl_b)) * y_l).astype(p_lat.dtype)
    out_c = ((hc_f + flip(hc_b)) * y_c).astype(p_ctx.dtype) if need_ctx else None
    return out_l, out_c


def blocked_attention(q, k, v):
    bsz, t = q.shape[:2]
    nb = t // Q_BLOCK
    qb = jnp.moveaxis(q.reshape(bsz, nb, Q_BLOCK, ATT_KV_HEADS, ATT_GROUP, HEAD_DIM), 1, 0)
    scale = HEAD_DIM ** -0.5

    def one_block(q_blk):
        s = jnp.einsum('bqkgd,bskd->bkgqs', q_blk, k, preferred_element_type=jnp.float32) * scale
        p = jax.nn.softmax(s, axis=-1)
        return jnp.einsum('bkgqs,bskd->bqkgd', p.astype(v.dtype), v)

    o = lax.map(one_block, qb)
    return jnp.moveaxis(o, 0, 1).reshape(bsz, t, ATT_WIDTH)


def attn_mixer(p_lat, p_ctx, q_norm_g, k_norm_g, cos, sin, need_ctx):
    def heads(p):
        bsz, t, _ = p.shape
        q = p[..., :ATT_WIDTH].reshape(bsz, t, ATT_Q_HEADS, HEAD_DIM)
        k = p[..., ATT_WIDTH:ATT_WIDTH + ATT_KV_WIDTH].reshape(bsz, t, ATT_KV_HEADS, HEAD_DIM)
        v = p[..., ATT_WIDTH + ATT_KV_WIDTH:].reshape(bsz, t, ATT_KV_HEADS, HEAD_DIM)
        return rms_norm(q, q_norm_g), rms_norm(k, k_norm_g), v

    qc, kc, vc = heads(p_ctx)
    ql, kl, vl = heads(p_lat)
    ql = apply_axial_rope(ql, cos, sin)
    kl = apply_axial_rope(kl, cos, sin)
    out_l = blocked_attention(ql, jnp.concatenate([kl, kc], axis=1), jnp.concatenate([vl, vc], axis=1))
    out_c = blocked_attention(qc, kc, vc) if need_ctx else None
    return out_l.astype(p_lat.dtype), (out_c.astype(p_ctx.dtype) if need_ctx else None)


def expert_mlp(xb, w1, w3, w2):
    return (jax.nn.silu(xb @ w1) * (xb @ w3)) @ w2


def hier_moe(tok, w_group, b_group, w_expert, b_expert, w1, w3, w2):
    n, d = tok.shape
    p_group = jax.nn.softmax((tok @ w_group).astype(jnp.float32) + b_group, axis=-1)
    pg_top, g_idx = lax.top_k(p_group, 1)
    le = ((tok @ w_expert).astype(jnp.float32) + b_expert).reshape(n, MOE_GROUPS, MOE_EXPERTS_PER_GROUP)
    le = le[jnp.arange(n), g_idx[:, 0]]
    pe_top, e_local = lax.top_k(jax.nn.softmax(le, axis=-1), MOE_TOP_K)
    gate = pg_top * pe_top / jnp.sum(pe_top, axis=-1, keepdims=True)
    expert = g_idx * MOE_EXPERTS_PER_GROUP + e_local
    nk = n * MOE_TOP_K
    flat_e = expert.reshape(-1)
    order = jnp.argsort(flat_e)
    sorted_e = flat_e[order]
    token_of = order // MOE_TOP_K
    counts = jnp.bincount(flat_e, length=MOE_EXPERTS)
    padded = (counts + MOE_BLOCK - 1) // MOE_BLOCK * MOE_BLOCK
    pad_end = jnp.cumsum(padded)
    start = jnp.cumsum(counts) - counts
    dest = (pad_end - padded)[sorted_e] + jnp.arange(nk) - start[sorted_e]
    n_blocks = -(-nk // MOE_BLOCK) + MOE_EXPERTS
    slot_tok = jnp.full((n_blocks * MOE_BLOCK,), n, dtype=token_of.dtype).at[dest].set(token_of)
    block_e = jnp.minimum(jnp.searchsorted(pad_end, jnp.arange(n_blocks) * MOE_BLOCK, side='right'),
                          MOE_EXPERTS - 1)
    tok_pad = jnp.concatenate([tok, jnp.zeros((1, d), tok.dtype)], axis=0)
    xb = tok_pad[slot_tok].reshape(n_blocks, MOE_BLOCK, d)
    yb = lax.map(lambda a: expert_mlp(a[0], w1[a[1]], w3[a[1]], w2[a[1]]), (xb, block_e))
    y = yb.reshape(-1, d)[dest] * gate.reshape(-1)[order][:, None].astype(tok.dtype)
    return jnp.zeros_like(tok).at[token_of].add(y)


def trunk_layer(x, xc, mod, mod_c, lp, cos, sin, need_ctx):
    sh1, sc1, g1, sh2, sc2, g2 = jnp.split(mod[:, None, :].astype(x.dtype), 6, axis=-1)
    csh1, csc1, cg1, csh2, csc2, cg2 = jnp.split(mod_c.astype(x.dtype), 6, axis=-1)
    proj = modulate(x, lp['norm1_g'], sh1, sc1) @ lp['w_in']
    proj_c = modulate(xc, lp['norm1_g'], csh1, csc1) @ lp['w_in']
    o1, o2 = GDN_PROJ, GDN_PROJ + LRU_PROJ
    a_l, a_c = gdn_mixer(proj[..., :o1], proj_c[..., :o1], lp['gdn_conv_w'], lp['gdn_a_log'],
                         lp['gdn_dt_bias'], lp['gdn_norm_g'], need_ctx)
    b_l, b_c = lru_mixer(proj[..., o1:o2], proj_c[..., o1:o2], lp['lru_conv_w'], lp['lru_conv_b'],
                         lp['lru_w_r'], lp['lru_b_r'], lp['lru_w_i'], lp['lru_b_i'], lp['lru_lambda'], need_ctx)
    c_l, c_c = attn_mixer(proj[..., o2:], proj_c[..., o2:], lp['attn_q_norm_g'], lp['attn_k_norm_g'],
                          cos, sin, need_ctx)
    x = x + g1 * (jnp.concatenate([a_l, b_l, c_l], axis=-1) @ lp['w_out'])
    moe = lambda t: hier_moe(t, lp['moe_w_group'], lp['moe_b_group'], lp['moe_w_expert'],
                             lp['moe_b_expert'], lp['moe_w1'], lp['moe_w3'], lp['moe_w2'])
    h = modulate(x, lp['norm2_g'], sh2, sc2)
    if need_ctx:
        xc = xc + cg1 * (jnp.concatenate([a_c, b_c, c_c], axis=-1) @ lp['w_out'])
        hc = modulate(xc, lp['norm2_g'], csh2, csc2)
        n_lat = h.shape[0] * h.shape[1]
        y = moe(jnp.concatenate([h.reshape(n_lat, -1), hc.reshape(-1, hc.shape[-1])], axis=0))
        x = x + g2 * y[:n_lat].reshape(x.shape)
        xc = xc + cg2 * y[n_lat:].reshape(xc.shape)
    else:
        x = x + g2 * moe(h.reshape(-1, h.shape[-1])).reshape(x.shape)
    return x, xc


def setup_inputs(seed: int = 0) -> dict:
    key = jax.random.key(seed)
    ks = iter(jax.random.split(key, 40))
    f32 = jnp.float32
    L, D = DEPTH, D_MODEL

    def nrm(shape, scale):
        return jax.random.normal(next(ks), shape, f32) * scale

    def gain(shape):
        return 1.0 + nrm(shape, 0.05)

    x = nrm((BATCH, SEQ, D), 1.0)
    c = nrm((BATCH, D), 1.0)
    ctx = nrm((BATCH, CTX_LEN, D), 1.0)
    c_ctx = nrm((D,), 1.0)
    w_ada = nrm((L, D, 6 * D), 0.3 * D ** -0.5)
    b_ada = nrm((L, 6 * D), 0.02)
    norm1_g = gain((L, D))
    norm2_g = gain((L, D))
    w_in = nrm((L, D, D_IN_PROJ), D ** -0.5)
    w_out = nrm((L, D_MIX, D), D_MIX ** -0.5)
    gdn_conv_w = nrm((L, SHORT_CONV, 3 * GDN_WIDTH), SHORT_CONV ** -0.5)
    gdn_a_log = jnp.log(jax.random.uniform(next(ks), (L, 2, GDN_HEADS), f32, minval=1.0, maxval=16.0))
    dt = jnp.exp(jax.random.uniform(next(ks), (L, 2, GDN_HEADS), f32,
                                    minval=math.log(1e-3), maxval=math.log(1e-1)))
    gdn_dt_bias = dt + jnp.log(-jnp.expm1(-dt))
    gdn_norm_g = gain((L, HEAD_DIM))
    lru_conv_w = nrm((L, SHORT_CONV, LRU_WIDTH), SHORT_CONV ** -0.5)
    lru_conv_b = nrm((L, LRU_WIDTH), 0.01)
    lru_w_r = nrm((L, 2, LRU_BLOCKS, LRU_BLOCK_W, LRU_BLOCK_W), LRU_BLOCK_W ** -0.5)
    lru_b_r = nrm((L, 2, LRU_WIDTH), 0.01)
    lru_w_i = nrm((L, 2, LRU_BLOCKS, LRU_BLOCK_W, LRU_BLOCK_W), LRU_BLOCK_W ** -0.5)
    lru_b_i = nrm((L, 2, LRU_WIDTH), 0.01)
    a0 = jax.random.uniform(next(ks), (L, 2, LRU_WIDTH), f32, minval=0.9, maxval=0.999)
    s = a0 ** (1.0 / LRU_C)
    lru_lambda = jnp.log(s) - jnp.log1p(-s)
    attn_q_norm_g = gain((L, HEAD_DIM))
    attn_k_norm_g = gain((L, HEAD_DIM))
    moe_w_group = nrm((L, D, MOE_GROUPS), D ** -0.5)
    moe_b_group = nrm((L, MOE_GROUPS), 0.01)
    moe_w_expert = nrm((L, D, MOE_EXPERTS), D ** -0.5)
    moe_b_expert = nrm((L, MOE_EXPERTS), 0.01)
    moe_w1 = nrm((L, MOE_EXPERTS, D, MOE_HIDDEN), D ** -0.5)
    moe_w3 = nrm((L, MOE_EXPERTS, D, MOE_HIDDEN), D ** -0.5)
    moe_w2 = nrm((L, MOE_EXPERTS, MOE_HIDDEN, D), MOE_HIDDEN ** -0.5)
    final_norm_g = gain((D,))
    return {'x': x, 'c': c, 'ctx': ctx, 'c_ctx': c_ctx, 'w_ada': w_ada, 'b_ada': b_ada,
            'norm1_g': norm1_g, 'norm2_g': norm2_g, 'w_in': w_in, 'w_out': w_out,
            'gdn_conv_w': gdn_conv_w, 'gdn_a_log': gdn_a_log, 'gdn_dt_bias': gdn_dt_bias,
            'gdn_norm_g': gdn_norm_g, 'lru_conv_w': lru_conv_w, 'lru_conv_b': lru_conv_b,
            'lru_w_r': lru_w_r, 'lru_b_r': lru_b_r, 'lru_w_i': lru_w_i, 'lru_b_i': lru_b_i,
            'lru_lambda': lru_lambda, 'attn_q_norm_g': attn_q_norm_g, 'attn_k_norm_g': attn_k_norm_g,
            'moe_w_group': moe_w_group, 'moe_b_group': moe_b_group, 'moe_w_expert': moe_w_expert,
            'moe_b_expert': moe_b_expert, 'moe_w1': moe_w1, 'moe_w3': moe_w3, 'moe_w2': moe_w2,
            'final_norm_g': final_norm_g}


def reference(x, c, ctx, c_ctx, w_ada, b_ada, norm1_g, norm2_g, w_in, w_out,
              gdn_conv_w, gdn_a_log, gdn_dt_bias, gdn_norm_g,
              lru_conv_w, lru_conv_b, lru_w_r, lru_b_r, lru_w_i, lru_b_i, lru_lambda,
              attn_q_norm_g, attn_k_norm_g,
              moe_w_group, moe_b_group, moe_w_expert, moe_b_expert, moe_w1, moe_w3, moe_w2,
              final_norm_g):
    rows = x.shape[1] // GRID_W
    cos, sin = axial_rope_tables(rows)
    silu_c = jax.nn.silu(c)
    silu_cc = jax.nn.silu(c_ctx)
    xc = ctx
    for l in range(DEPTH):
        mod = silu_c @ w_ada[l] + b_ada[l]
        mod_c = silu_cc @ w_ada[l] + b_ada[l]
        lp = {'norm1_g': norm1_g[l], 'norm2_g': norm2_g[l], 'w_in': w_in[l], 'w_out': w_out[l],
              'gdn_conv_w': gdn_conv_w[l], 'gdn_a_log': gdn_a_log[l], 'gdn_dt_bias': gdn_dt_bias[l],
              'gdn_norm_g': gdn_norm_g[l], 'lru_conv_w': lru_conv_w[l], 'lru_conv_b': lru_conv_b[l],
              'lru_w_r': lru_w_r[l], 'lru_b_r': lru_b_r[l], 'lru_w_i': lru_w_i[l], 'lru_b_i': lru_b_i[l],
              'lru_lambda': lru_lambda[l], 'attn_q_norm_g': attn_q_norm_g[l],
              'attn_k_norm_g': attn_k_norm_g[l], 'moe_w_group': moe_w_group[l],
              'moe_b_group': moe_b_group[l], 'moe_w_expert': moe_w_expert[l],
              'moe_b_expert': moe_b_expert[l], 'moe_w1': moe_w1[l], 'moe_w3': moe_w3[l],
              'moe_w2': moe_w2[l]}
        x, xc = trunk_layer(x, xc, mod, mod_c, lp, cos, sin, need_ctx=l < DEPTH - 1)
    return rms_norm(x, final_norm_g)
```

```cpp
#ifndef HOST_EMU
#include <hip/hip_runtime.h>
#endif
#include <cstdio>
#include <cstdint>
#include <cmath>


#ifndef CFG_D
#define CFG_D 1024
#define CFG_B 8
#define CFG_SEQ 2048
#define CFG_DEPTH 4
#define CFG_CTX 256
#define CFG_HID 512
#endif

#ifdef HOST_EMU
#define HIDE(x)
#define VZ 0
#define STORE_WT(ptr, v) (*(ptr) = (v))
#define DEV static inline
#define HD_INLINE static inline
static inline int atomicAdd(int* p, int v) { int o = *p; *p = o + v; return o; }
#else
#define HIDE(x) asm volatile("" : "+v"(x))
#define VZ ({ int z_ = 0; asm volatile("" : "+v"(z_)); z_; })
#define STORE_WT(ptr, v) __hip_atomic_store((ptr), (v), __ATOMIC_RELAXED, __HIP_MEMORY_SCOPE_AGENT)
#define DEV __device__ __forceinline__
#endif

constexpr int D = CFG_D, NB = CFG_B, SEQ = CFG_SEQ, DEPTH = CFG_DEPTH, CTX = CFG_CTX, HID = CFG_HID;
constexpr int HD = 64, GW = D / 4, GH = GW / HD, LW = D / 4, LBW = LW / 4, AW = D - GW - LW, AQH = AW / HD, AKH = 2, AG = AQH / AKH, KVW = AKH * HD;
constexpr int GP = 4 * GW + 4 * GH, LP = 2 * LW, AP = AW + 2 * KVW, PJ = GP + LP + AP;
constexpr int O_L = GP, O_A = GP + LP;
constexpr int NL = NB * SEQ, NC = NB * CTX, NT = NL + NC;
constexpr int NE = 64, NG = 8, EPG = 8, NLOG = NG + NE;
constexpr int MBLK = 256, NPJ = ((PJ + 255) / 256) * 256, PJS = NPJ  , NSLOT = NT * 2 + NE * MBLK, NBLK = NSLOT / MBLK;
constexpr int H2S = 3 * D;
constexpr int KK = SEQ + CTX;
constexpr float EPS = 1e-6f, QSCALE = 0.125f * 1.4426950408889634f;
static_assert(NSLOT % MBLK == 0, "slots");

typedef unsigned short bf16_t;
struct P {
    const float *x, *c, *ctx, *c_ctx, *w_ada, *b_ada, *norm1_g, *norm2_g, *w_in, *w_out, *gdn_conv_w, *gdn_a_log, *gdn_dt_bias, *gdn_norm_g;
    const float *lru_conv_w, *lru_conv_b, *lru_w_r, *lru_b_r, *lru_w_i, *lru_b_i, *lru_lambda, *attn_q_norm_g, *attn_k_norm_g;
    const float *moe_w_group, *moe_b_group, *moe_w_expert, *moe_b_expert, *moe_w1, *moe_w3, *moe_w2, *final_norm_g;
    float* out;
    unsigned* bar;
    float *AB, *LOGIT, *X, *MOD, *PART, *ROPE, *CARRY, *PROJ, *GQKV, *GG, *GB, *GO, *LXR, *LA, *LBX, *LH, *AQ, *AK, *RG, *Y;
    int *RE, *CNT, *OFF, *BLKE, *SLOT_TOK, *SLOT_OF;
    bf16_t *Yb, *HNb, *MIXb, *H2b, *ACTb, *WinT, *WoutT, *W13T, *W2T, *WrT, *WlT, *LXRb, *PROJb, *AQb, *Kc, *Vt, *GWN, *GQG, *GQK, *GKT;
    float *GU, *GEL;
};

#ifdef HOST_EMU
DEV float fexp(float x) { return expf(x); }
DEV float flog(float x) { return logf(x); }
DEV float frcp(float x) { return 1.0f / x; }
DEV float frsq(float x) { return 1.0f / sqrtf(x); }
#else
DEV float fexp(float x) { return __expf(x); }
DEV float flog(float x) { return __logf(x); }
DEV float frcp(float x) { return __builtin_amdgcn_rcpf(x); }
DEV float frsq(float x) { return __builtin_amdgcn_rsqf(x); }
#endif
DEV float siluf(float x) { return x * frcp(1.f + fexp(-x)); }
DEV float sigmoidf(float x) { return frcp(1.f + fexp(-x)); }
DEV float softplusf(float x) { if (x > 15.f) return x; const float e = fexp(x); return e < 1e-3f ? e * (1.f - 0.5f * e) : flog(1.f + e); }
DEV float neg_expm1f(float y) { return fabsf(y) < 0.01f ? -y * (1.f + y * (0.5f + y * 0.16666667f)) : 1.f - fexp(y); }
DEV float gelu_tanhf(float x) { const float u = 0.7978845608028654f * (x + 0.044715f * x * x * x); return x * frcp(1.f + fexp(-2.f * u)); }
DEV bf16_t f2bf(float f) { unsigned u = __builtin_bit_cast(unsigned, f); return (bf16_t)((u + 0x7fffu + ((u >> 16) & 1u)) >> 16); }
DEV float bf2f(bf16_t h) { return __builtin_bit_cast(float, (unsigned)h << 16); }
DEV int tok_modrow(int n) { return n < NL ? n / SEQ : NB; }
DEV void tok_seg(int n, int& s0, int& len) { if (n < NL) { s0 = (n / SEQ) * SEQ; len = SEQ; } else { s0 = NL + ((n - NL) / CTX) * CTX; len = CTX; } }

DEV void ph_mod(const P& p, long gtid, long gsize) {
    for (long it = gtid; it < (long)DEPTH * 6 * D; it += gsize) {
        const int l = (int)(it / (6 * D)), j = (int)(it % (6 * D));
        float acc[NB + 1];
#pragma unroll
        for (int r = 0; r <= NB; ++r) acc[r] = 0.f;
        const float* w = p.w_ada + (size_t)l * D * 6 * D + j;
        for (int k = 0; k < D; ++k) {
            const float wv = w[(size_t)k * 6 * D];
#pragma unroll
            for (int r = 0; r <= NB; ++r) { const float cv = r < NB ? p.c[r * D + k] : p.c_ctx[k]; acc[r] += siluf(cv) * wv; }
        }
        const float bv = p.b_ada[l * 6 * D + j];
#pragma unroll
        for (int r = 0; r <= NB; ++r) p.MOD[((size_t)l * (NB + 1) + r) * 6 * D + j] = acc[r] + bv;
    }
}
DEV void ph_rope(const P& p, long gtid, long gsize) {
    for (long it = gtid; it < (long)SEQ * 16; it += gsize) {
        const int t = (int)(it / 16), i = (int)(it % 16);
        const float inv = powf(10000.0f, -(float)(2 * i) / 32.0f), ar = (float)(t / 64) * inv, ac = (float)(t % 64) * inv;
        float* rt = p.ROPE + (size_t)t * 64;
        rt[i] = cosf(ar); rt[16 + i] = sinf(ar); rt[32 + i] = cosf(ac); rt[48 + i] = sinf(ac);
    }
}
DEV void ph_init(const P& p, long gtid, long gsize) {
    for (long it = gtid; it < (long)NT * D; it += gsize) p.X[it] = it < (long)NL * D ? p.x[it] : p.ctx[it - (long)NL * D];
}
DEV void norm_row(const P& p, int l, int n, int which, bf16_t* dst) {
    const float* xr = p.X + (size_t)n * D;
    float ss = 0.f;
    for (int k = 0; k < D; ++k) ss += xr[k] * xr[k];
    const float rs = frsq(ss / D + EPS);
    const float* g = (which ? p.norm2_g : p.norm1_g) + l * D;
    const float* md = p.MOD + ((size_t)l * (NB + 1) + tok_modrow(n)) * 6 * D + (which ? 3 * D : 0);
    for (int k = 0; k < D; ++k) dst[k] = f2bf(xr[k] * rs * g[k] * (1.f + md[D + k]) + md[k]);
}
DEV void ph_norm1_aux(const P& p, long gtid, long gsize);
DEV void ph_norm1(const P& p, int l, long gtid, long gsize) {
    for (long it = gtid; it < NT; it += gsize) norm_row(p, l, (int)it, 0, p.HNb + (size_t)it * D);
    ph_norm1_aux(p, gtid, gsize);
}
DEV void ph_norm1_aux(const P& p, long gtid, long gsize) {
    for (long it = gtid; it < NE; it += gsize) p.CNT[it] = 0;
}

template <bool DUAL, class RowA, class Epi>
DEV void gemm_naive(int Mtiles, int N, int K, RowA rowA, const float* B, const float* B2, int ldb, Epi epi, long gtid, long gsize) {
    const int nt = N / 4;
    for (long it = gtid; it < (long)Mtiles * nt; it += gsize) {
        const int mt = (int)(it / nt), n0 = (int)(it % nt) * 4;
        const bf16_t* a[4]; const float* Bb = B; const float* Bb2 = B2; bool any = false;
#pragma unroll
        for (int i = 0; i < 4; ++i) { a[i] = rowA(mt * 4 + i, Bb, Bb2); any |= a[i] != nullptr; }
        if (!any) continue;
        float acc[4][4], acc2[4][4];
#pragma unroll
        for (int i = 0; i < 4; ++i)
#pragma unroll
            for (int j = 0; j < 4; ++j) { acc[i][j] = 0.f; acc2[i][j] = 0.f; }
        for (int k = 0; k < K; ++k) {
            const float* bp = Bb + (size_t)k * ldb + n0;
            const float b0 = bp[0], b1 = bp[1], b2 = bp[2], b3 = bp[3];
            float c0 = 0, c1 = 0, c2 = 0, c3 = 0;
            if (DUAL) { const float* bq = Bb2 + (size_t)k * ldb + n0; c0 = bq[0]; c1 = bq[1]; c2 = bq[2]; c3 = bq[3]; }
#pragma unroll
            for (int i = 0; i < 4; ++i) {
                const float av = a[i] ? bf2f(a[i][k]) : 0.f;
                acc[i][0] += av * b0; acc[i][1] += av * b1; acc[i][2] += av * b2; acc[i][3] += av * b3;
                if (DUAL) { acc2[i][0] += av * c0; acc2[i][1] += av * c1; acc2[i][2] += av * c2; acc2[i][3] += av * c3; }
            }
        }
#pragma unroll
        for (int i = 0; i < 4; ++i) if (a[i]) epi(mt * 4 + i, n0, acc[i], acc2[i]);
    }
}

DEV void ph_inproj(const P& p, int l, long gtid, long gsize) {
    const float* W = p.w_in + (size_t)l * D * PJ;
    gemm_naive<false>(NT / 4, PJ, D,
        [&](int m, const float*&, const float*&) { return p.HNb + (size_t)m * D; }, W, nullptr, PJ,
        [&](int m, int n0, const float* acc, const float*) { float* o = p.PROJ + (size_t)m * PJS + n0; o[0] = acc[0]; o[1] = acc[1]; o[2] = acc[2]; o[3] = acc[3]; },
        gtid, gsize);
}

DEV float conv4(const P& p, int n, int s0, int len, const float* w, int wstride, int c, int col) {
    float acc = 0.f;
#pragma unroll
    for (int j = 0; j < 4; ++j) { const int m = n + j - 1; if (m >= s0 && m < s0 + len) acc += w[j * wstride + c] * p.PROJ[(size_t)m * PJS + col]; }
    return acc;
}
DEV void ph_prep(const P& p, int l, long gtid, long gsize) {
    for (long it = gtid; it < (long)NT * 3 * GH; it += gsize) {
        const int n = (int)(it / (3 * GH)), wh = (int)(it % (3 * GH)), which = wh / GH, h = wh % GH;
        int s0, len; tok_seg(n, s0, len);
        const float* w = p.gdn_conv_w + (size_t)l * 4 * 3 * GW;
        float* o = p.GQKV + (size_t)n * 3 * GW + which * GW + h * HD;
        float ss = 0.f;
        for (int d = 0; d < HD; ++d) { const int c = which * GW + h * HD + d; const float v = siluf(conv4(p, n, s0, len, w, 3 * GW, c, c)); ss += v * v; o[d] = v; }
        if (which < 2) {
            float sc = frsq(ss + EPS); if (which == 0) sc *= 0.125f;
            for (int d = 0; d < HD; ++d) o[d] *= sc;
        }
    }
    for (long it = gtid; it < (long)NT * 2 * GH; it += gsize) {
        const int n = (int)(it / (2 * GH)), dh = (int)(it % (2 * GH));
        const float al = p.PROJ[(size_t)n * PJS + 4 * GW + dh], be = p.PROJ[(size_t)n * PJS + 4 * GW + 2 * GH + dh];
        p.GG[it] = -fexp(p.gdn_a_log[l * 2 * GH + dh]) * softplusf(al + p.gdn_dt_bias[l * 2 * GH + dh]);
        p.GB[it] = sigmoidf(be);
    }
    for (long it = gtid; it < (long)NT * LW; it += gsize) {
        const int n = (int)(it / LW), c = (int)(it % LW);
        int s0, len; tok_seg(n, s0, len);
        const float xv = conv4(p, n, s0, len, p.lru_conv_w + (size_t)l * 4 * LW, LW, c, O_L + c) + p.lru_conv_b[l * LW + c];
        p.LXR[it] = xv; p.LXRb[it] = f2bf(xv);
    }
    for (long it = gtid; it < (long)NT * (AQH + AKH); it += gsize) {
        const int n = (int)(it / (AQH + AKH)), hh = (int)(it % (AQH + AKH));
        const bool isq = hh < AQH;
        const float* src = p.PROJ + (size_t)n * PJS + O_A + (isq ? hh * HD : AW + (hh - AQH) * HD);
        const float* g = (isq ? p.attn_q_norm_g : p.attn_k_norm_g) + l * HD;
        float ss = 0.f;
        for (int d = 0; d < HD; ++d) ss += src[d] * src[d];
        const float rs = frsq(ss / HD + EPS);
        float* o = isq ? p.AQ + (size_t)n * AW + hh * HD : p.AK + (size_t)n * KVW + (hh - AQH) * HD;
        if (n < NL) {
            const int t = n % SEQ;
            const float* rt = p.ROPE + (size_t)t * 64;
            for (int i = 0; i < 16; ++i) {
                const float cr = rt[i], sr = rt[16 + i], cc = rt[32 + i], sc = rt[48 + i];
                const float x1 = src[i] * rs * g[i], x2 = src[16 + i] * rs * g[16 + i], y1 = src[32 + i] * rs * g[32 + i], y2 = src[48 + i] * rs * g[48 + i];
                o[i] = x1 * cr - x2 * sr; o[16 + i] = x1 * sr + x2 * cr;
                o[32 + i] = y1 * cc - y2 * sc; o[48 + i] = y1 * sc + y2 * cc;
            }
        } else {
            for (int d = 0; d < HD; ++d) o[d] = src[d] * rs * g[d];
        }
        const int b = n < NL ? n / SEQ : (n - NL) / CTX, kk = n < NL ? n % SEQ : SEQ + (n - NL) % CTX;
        if (isq) { bf16_t* qb = p.AQb + (size_t)n * AW + hh * HD; for (int d = 0; d < HD; ++d) qb[d] = f2bf(o[d] * QSCALE); }
        else {
            const int kvh = hh - AQH;
            bf16_t* kb = p.Kc + ((size_t)(b * AKH + kvh) * KK + kk) * HD; for (int d = 0; d < HD; ++d) kb[d] = f2bf(o[d]);
        }
    }
    for (long it = gtid; it < (long)NB * AKH * (KK / 64) * HD; it += gsize) {
        const int d = (int)(it % HD), kb = (int)(it / HD) % (KK / 64), kvh = (int)(it / (HD * (KK / 64))) % AKH, b = (int)(it / (HD * (KK / 64) * AKH));
        const int n0 = kb * 64 < SEQ ? b * SEQ + kb * 64 : NL + b * CTX + (kb * 64 - SEQ);
        const float* vsrc = p.PROJ + (size_t)n0 * PJS + O_A + AW + KVW + kvh * HD + d;
        bf16_t* vb = p.Vt + ((size_t)(b * AKH + kvh) * HD + d) * KK + kb * 64;
        for (int i = 0; i < 64; i += 2) { const unsigned w = (unsigned)f2bf(vsrc[(size_t)i * PJS]) | ((unsigned)f2bf(vsrc[(size_t)(i + 1) * PJS]) << 16); *(unsigned*)(vb + i) = w; }
    }
}
constexpr int NCH = (CTX + SEQ) / 64, NCC = CTX / 64;
DEV int chunk_tok(int b, int dir, int ci, int i) {
    if (ci < NCC) { const int pos = ci * 64 + i; return NL + b * CTX + (dir ? CTX - 1 - pos : pos); }
    const int pos = (ci - NCC) * 64 + i; return b * SEQ + (dir ? SEQ - 1 - pos : pos);
}
DEV int tok_chunk(int n, int dir) {
    if (n < NL) { const int t = n % SEQ; return NCC + (dir ? SEQ - 1 - t : t) / 64; }
    const int sidx = (n - NL) % CTX; return (dir ? CTX - 1 - sidx : sidx) / 64;
}
DEV void ph_lru_local(const P& p, int l, long gtid, long gsize) {
    for (long it = gtid; it < (long)NB * 2 * NCH * LW; it += gsize) {
        const int c = (int)(it % LW), ci = (int)(it / LW) % NCH, dir = (int)(it / (LW * NCH)) % 2, b = (int)(it / (LW * NCH * 2)), blk = c / LBW, e = c % LBW;
        const float* wr = p.lru_w_r + ((size_t)(l * 2 + dir) * 4 + blk) * LBW * LBW + e;
        const float* wi = p.lru_w_i + ((size_t)(l * 2 + dir) * 4 + blk) * LBW * LBW + e;
        const float br = p.lru_b_r[(l * 2 + dir) * LW + c], bi = p.lru_b_i[(l * 2 + dir) * LW + c], sp = softplusf(-p.lru_lambda[(l * 2 + dir) * LW + c]);
        float h = 0.f, A = 1.f;
        for (int i = 0; i < 64; ++i) {
            const int n = chunk_tok(b, dir, ci, i);
            const float* xr = p.LXR + (size_t)n * LW + blk * LBW;
            float ar = 0.f, ai = 0.f;
            for (int d = 0; d < LBW; ++d) { const float xv = xr[d]; ar += xv * wr[d * LBW]; ai += xv * wi[d * LBW]; }
            const float r = sigmoidf(ar + br), ig = sigmoidf(ai + bi), log_a = -8.0f * r * sp, a = fexp(log_a);
            const float bx = sqrtf(neg_expm1f(2.0f * log_a)) * (ig * p.LXR[(size_t)n * LW + c]);
            h = a * h + bx; A *= a;
            const size_t ix = ((size_t)dir * NT + n) * LW + c;
            p.LH[ix] = h; p.LA[ix] = A;
        }
    }
}
#ifndef HOST_EMU
__device__ __forceinline__ void ph_lru_carry_w(const P& p, long gtid, long gsize) {
    const bf16_t* LHb = (const bf16_t*)p.LH; const bf16_t* LAb = LHb + (size_t)2 * NT * LW;
    for (long it = gtid; it < (long)NB * 2 * LW; it += gsize) {
        const int c = (int)(it % LW), dir = (int)(it / LW) % 2, b = (int)(it / (2 * LW));
        float H = 0.f;
        for (int ci = 0; ci < NCH; ++ci) {
            p.CARRY[((size_t)(b * 2 + dir) * NCH + ci) * LW + c] = H;
            const size_t ix = ((size_t)dir * NT + chunk_tok(b, dir, ci, 63)) * LW + c;
            H = bf2f(LAb[ix]) * H + bf2f(LHb[ix]);
        }
    }
}
#endif
DEV void ph_lru_carry(const P& p, long gtid, long gsize) {
    for (long it = gtid; it < (long)NB * 2 * LW; it += gsize) {
        const int c = (int)(it % LW), dir = (int)(it / LW) % 2, b = (int)(it / (2 * LW));
        float H = 0.f;
        for (int ci = 0; ci < NCH; ++ci) {
            p.CARRY[((size_t)(b * 2 + dir) * NCH + ci) * LW + c] = H;
            const size_t ix = ((size_t)dir * NT + chunk_tok(b, dir, ci, 63)) * LW + c;
            H = p.LA[ix] * H + p.LH[ix];
        }
    }
}
DEV void ph_gdn_naive(const P& p, int l, long gtid, long gsize) {
    for (long it = gtid; it < (long)NB * GH * 2 * HD; it += gsize) {
        const int dv = (int)(it % HD), dir = (int)(it / HD) % 2, h = (int)(it / (2 * HD)) % GH, b = (int)(it / (2 * HD * GH));
        float S[HD];
#pragma unroll
        for (int d = 0; d < HD; ++d) S[d] = 0.f;
        for (int ph = 0; ph < 2; ++ph) {
            const int len = ph == 0 ? CTX : SEQ, base = ph == 0 ? NL + b * CTX : b * SEQ;
            for (int i = 0; i < len; ++i) {
                const int n = base + (dir == 0 ? i : len - 1 - i);
                const float a = fexp(p.GG[(size_t)n * 2 * GH + dir * GH + h]), bt = p.GB[(size_t)n * 2 * GH + dir * GH + h];
                const float* q = p.GQKV + (size_t)n * 3 * GW + h * HD; const float* k = q + GW; const float v = q[2 * GW + dv];
                float ks = 0.f;
#pragma unroll
                for (int d = 0; d < HD; ++d) { S[d] *= a; ks += k[d] * S[d]; }
                const float cc = bt * (v - ks); float o = 0.f;
#pragma unroll
                for (int d = 0; d < HD; ++d) { S[d] += k[d] * cc; o += q[d] * S[d]; }
                p.GO[((size_t)dir * NT + n) * GW + h * HD + dv] = o;
            }
        }
    }
}
DEV void ph_attn(const P& p, int l, int ntok, long gtid, long gsize) {
    for (long it = gtid; it < (long)ntok * AQH; it += gsize) {
        const int n = (int)(it / AQH), hq = (int)(it % AQH), kvh = hq / AG;
        const float* qp = p.AQ + (size_t)n * AW + hq * HD;
        float q[HD], o[HD];
#pragma unroll
        for (int d = 0; d < HD; ++d) { q[d] = qp[d] * 0.125f; o[d] = 0.f; }
        float m = -1e30f, lsum = 0.f;
        const int b = n < NL ? n / SEQ : (n - NL) / CTX;
        for (int ph = (n < NL ? 0 : 1); ph < 2; ++ph) {
            const int len = ph == 0 ? SEQ : CTX, base = ph == 0 ? b * SEQ : NL + b * CTX;
            for (int j = 0; j < len; ++j) {
                const float* kp = p.AK + (size_t)(base + j) * KVW + kvh * HD;
                const float* vp = p.PROJ + (size_t)(base + j) * PJS + O_A + AW + KVW + kvh * HD;
                float s = 0.f;
#pragma unroll
                for (int d = 0; d < HD; ++d) s += q[d] * kp[d];
                const float mn = fmaxf(m, s), corr = fexp(m - mn), pe = fexp(s - mn);
                lsum = lsum * corr + pe;
#pragma unroll
                for (int d = 0; d < HD; ++d) o[d] = o[d] * corr + pe * vp[d];
                m = mn;
            }
        }
        const float inv = 1.f / lsum; bf16_t* op = p.MIXb + (size_t)n * D + GW + LW + hq * HD;
#pragma unroll
        for (int d = 0; d < HD; ++d) op[d] = f2bf(o[d] * inv);
    }
}
DEV void ph_readout(const P& p, int l, int ntok, long gtid, long gsize) {
    for (long it = gtid; it < (long)ntok * GH; it += gsize) {
        const int n = (int)(it / GH), h = (int)(it % GH);
        const float* o0 = p.GO + (size_t)n * GW + h * HD; const float* o1 = p.GO + ((size_t)NT + n) * GW + h * HD;
        const float* gate = p.PROJ + (size_t)n * PJS + 3 * GW + h * HD; const float* g = p.gdn_norm_g + l * HD;
        float v[HD]; float ss = 0.f;
#pragma unroll
        for (int d = 0; d < HD; ++d) { v[d] = o0[d] + o1[d]; ss += v[d] * v[d]; }
        const float rs = frsq(ss / HD + EPS); bf16_t* op = p.MIXb + (size_t)n * D + h * HD;
#pragma unroll
        for (int d = 0; d < HD; ++d) op[d] = f2bf(v[d] * rs * g[d] * siluf(gate[d]));
    }
    for (long it = gtid; it < (long)ntok * LW; it += gsize) {
        const int n = (int)(it / LW), c = (int)(it % LW);
        const int bb = n < NL ? n / SEQ : (n - NL) / CTX;
        float hs = 0.f;
#pragma unroll
        for (int d = 0; d < 2; ++d) { const size_t ix = ((size_t)d * NT + n) * LW + c; hs += p.LH[ix] + p.LA[ix] * p.CARRY[((size_t)(bb * 2 + d) * NCH + tok_chunk(n, d)) * LW + c]; }
        p.MIXb[(size_t)n * D + GW + c] = f2bf(hs * gelu_tanhf(p.PROJ[(size_t)n * PJS + O_L + LW + c]));
    }
}
DEV void ph_outproj(const P& p, int l, int ntok, long gtid, long gsize) {
    const float* W = p.w_out + (size_t)l * D * D;
    gemm_naive<false>(ntok / 4, D, D,
        [&](int m, const float*&, const float*&) { return p.MIXb + (size_t)m * D; }, W, nullptr, D,
        [&](int m, int n0, const float* acc, const float*) {
            const float* g1 = p.MOD + ((size_t)l * (NB + 1) + tok_modrow(m)) * 6 * D + 2 * D + n0; float* o = p.X + (size_t)m * D + n0;
            o[0] += g1[0] * acc[0]; o[1] += g1[1] * acc[1]; o[2] += g1[2] * acc[2]; o[3] += g1[3] * acc[3]; },
        gtid, gsize);
}
DEV void ph_route(const P& p, int l, int ntok, long gtid, long gsize) {
    for (long it = gtid; it < ntok; it += gsize) {
        const int n = (int)it; bf16_t* h = p.H2b + (size_t)n * H2S;
        norm_row(p, l, n, 1, h);
        float lg[NLOG];
#pragma unroll
        for (int j = 0; j < NG; ++j) lg[j] = p.moe_b_group[l * NG + j];
#pragma unroll
        for (int j = 0; j < NE; ++j) lg[NG + j] = p.moe_b_expert[l * NE + j];
        const float* wg = p.moe_w_group + (size_t)l * D * NG; const float* we = p.moe_w_expert + (size_t)l * D * NE;
        for (int k = 0; k < D; ++k) {
            const float hv = bf2f(h[k]);
#pragma unroll
            for (int j = 0; j < NG; ++j) lg[j] += hv * wg[k * NG + j];
#pragma unroll
            for (int j = 0; j < NE; ++j) lg[NG + j] += hv * we[k * NE + j];
        }
        int gi = 0; float gm = lg[0];
#pragma unroll
        for (int j = 1; j < NG; ++j) if (lg[j] > gm) { gm = lg[j]; gi = j; }
        float gs = 0.f;
#pragma unroll
        for (int j = 0; j < NG; ++j) gs += fexp(lg[j] - gm);
        const float pg = 1.f / gs;
        float e1 = -1e30f, e2 = -1e30f; int i1 = 0, i2 = 0;
#pragma unroll
        for (int g = 0; g < NG; ++g) if (g == gi) {
#pragma unroll
            for (int j = 0; j < EPG; ++j) { const float v = lg[NG + g * EPG + j]; if (v > e1) { e2 = e1; i2 = i1; e1 = v; i1 = j; } else if (v > e2) { e2 = v; i2 = j; } }
        }
        const float w2 = fexp(e2 - e1), inv = 1.f / (1.f + w2);
        const int ex0 = gi * EPG + i1, ex1 = gi * EPG + i2;
        p.RE[n * 2] = ex0; p.RE[n * 2 + 1] = ex1; p.RG[n * 2] = pg * inv; p.RG[n * 2 + 1] = pg * w2 * inv;
        atomicAdd(&p.CNT[ex0], 1); atomicAdd(&p.CNT[ex1], 1);
    }
}
DEV void ph_offsets(const P& p, long gtid, long gsize) {
    if (gtid == 0) {
        int off = 0;
        for (int e = 0; e < NE; ++e) { p.OFF[e * 32] = off; const int pad = (p.CNT[e] + MBLK - 1) / MBLK * MBLK; for (int b = off / MBLK; b < (off + pad) / MBLK; ++b) p.BLKE[b * 32] = e; off += pad; }
        p.OFF[NE * 32] = off;
        for (int b = off / MBLK; b < NBLK; ++b) p.BLKE[b * 32] = -1;
    }
}
DEV void ph_slots(const P& p, int ntok, long gtid, long gsize) {
    for (long e = gtid; e < NE; e += gsize) {
        int s = p.OFF[e * 32];
        for (int i = 0; i < ntok * 2; ++i) if (p.RE[i] == (int)e) { p.SLOT_TOK[s] = i >> 1; p.SLOT_OF[(size_t)i * 32] = s; ++s; }
        for (; s < p.OFF[(e + 1) * 32]; ++s) p.SLOT_TOK[s] = -1;
    }
}
DEV void ph_moe1(const P& p, int l, long gtid, long gsize) {
    gemm_naive<true>(NSLOT / 4, HID, D,
        [&](int m, const float*& B, const float*& B2) -> const bf16_t* {
            const int e = p.BLKE[(m / MBLK) * 32]; if (e < 0) return nullptr;
            B = p.moe_w1 + ((size_t)l * NE + e) * D * HID; B2 = p.moe_w3 + ((size_t)l * NE + e) * D * HID;
            const int t = p.SLOT_TOK[m]; return t < 0 ? nullptr : p.H2b + (size_t)t * H2S; },
        nullptr, nullptr, HID,
        [&](int m, int n0, const float* a1, const float* a3) { bf16_t* o = p.ACTb + (size_t)m * HID + n0;
#pragma unroll
            for (int j = 0; j < 4; ++j) o[j] = f2bf(siluf(a1[j]) * a3[j]); },
        gtid, gsize);
}
DEV void ph_moe2(const P& p, int l, long gtid, long gsize) {
    gemm_naive<false>(NSLOT / 4, D, HID,
        [&](int m, const float*& B, const float*&) -> const bf16_t* {
            const int e = p.BLKE[(m / MBLK) * 32]; if (e < 0) return nullptr;
            B = p.moe_w2 + ((size_t)l * NE + e) * HID * D;
            return p.SLOT_TOK[m] < 0 ? nullptr : p.ACTb + (size_t)m * HID; },
        nullptr, nullptr, D,
        [&](int m, int n0, const float* acc, const float*) { float* o = p.Y + (size_t)m * D + n0; o[0] = acc[0]; o[1] = acc[1]; o[2] = acc[2]; o[3] = acc[3]; },
        gtid, gsize);
}
DEV void ph_combine(const P& p, int l, int ntok, long gtid, long gsize) {
    for (long it = gtid; it < (long)ntok * D; it += gsize) {
        const int n = (int)(it / D), j = (int)(it % D);
        const float g2 = p.MOD[((size_t)l * (NB + 1) + tok_modrow(n)) * 6 * D + 5 * D + j];
        const float y = p.RG[n * 2] * p.Y[(size_t)p.SLOT_OF[(size_t)n * 64] * D + j] + p.RG[n * 2 + 1] * p.Y[(size_t)p.SLOT_OF[(size_t)n * 64 + 32] * D + j];
        p.X[it] += g2 * y;
    }
}
DEV void ph_final(const P& p, long gtid, long gsize) {
    for (long it = gtid; it < NL; it += gsize) {
        const float* xr = p.X + (size_t)it * D; float ss = 0.f;
        for (int k = 0; k < D; ++k) ss += xr[k] * xr[k];
        const float rs = frsq(ss / D + EPS);
        for (int k = 0; k < D; ++k) p.out[(size_t)it * D + k] = xr[k] * rs * p.final_norm_g[k];
    }
}


#ifndef HOST_EMU
#define LAS __attribute__((address_space(3)))
namespace pg8 {
typedef short bf16x8 __attribute__((ext_vector_type(8)));
typedef float f32x4 __attribute__((ext_vector_type(4)));
typedef unsigned u32x4 __attribute__((ext_vector_type(4)));
typedef unsigned u32x2 __attribute__((ext_vector_type(2)));
constexpr int BM = 256, BK = 64, HALF = 128, HTB = HALF * BK * 2, STAGE_BYTES = 8 * HTB, NXCD = 8, WGM = 8;
__device__ __forceinline__ int lds_byte(int r, int c) { const int st = (r >> 4) * 2 + (c >> 5), rr = r & 15, cc = c & 31, ob = rr * 64 + cc * 2; return st * 1024 + (ob ^ (((ob >> 9) & 1) << 5)); }
__device__ __forceinline__ void stage_rc(int b, int& R, int& C) { const int st = b / 1024, sb = b % 1024, swz = sb ^ (((sb >> 9) & 1) << 5); R = (st >> 1) * 16 + swz / 64; C = (st & 1) * 32 + (swz % 64) / 2; }
__device__ __forceinline__ int perm32(int rho) { const int n = rho >> 4, i = rho & 15; return 8 * (i >> 2) + 4 * n + (i & 3); }
typedef float f32x2c __attribute__((ext_vector_type(2))); typedef __bf16 bf16x2c __attribute__((ext_vector_type(2)));
__device__ __forceinline__ unsigned cvt_pk_bf16(float lo, float hi) { const f32x2c v = {lo, hi}; return __builtin_bit_cast(unsigned, __builtin_convertvector(v, bf16x2c)); }

struct Unit { int row0, col0; const char* B; const int* rows; int aoff; };

struct DenseSched {
    int nM, nN, nwg, G, c; const char* Bt; int K;
    __device__ void init(int M, int N, int K_, const void* Bt_, int G_, int c_) { nM = M / BM; nN = N / BM; nwg = nM * nN; G = G_; c = c_; Bt = (const char*)Bt_; K = K_; }
    __device__ bool next(int i, Unit& u) const {
        const long L = (long)i * G + c; if (L >= nwg) return false;
        int wgid = (int)L; { const int q = nwg / NXCD, r = nwg % NXCD, xcd = wgid % NXCD, off = wgid / NXCD; wgid = (xcd < r ? xcd * (q + 1) : r * (q + 1) + (xcd - r) * q) + off; }
        const int nig = WGM * nN, gid = wgid / nig, fm = gid * WGM, gsz = (nM - fm) < WGM ? (nM - fm) : WGM;
        const int pm = fm + ((wgid % nig) % gsz), pn = (wgid % nig) / gsz;
        u.row0 = pm * BM; u.col0 = pn * BM; u.B = Bt + (size_t)pn * BM * K * 2; u.rows = nullptr; u.aoff = 0; return true;
    }
};
struct MoeSched {
    int nunits, G, c; const char* W; size_t estride; int K; const int* blke; const int* rows;
    __device__ bool next(int i, Unit& u) const {
        const long L = (long)i * G + c; if (L >= nunits) return false;
        const int pm = (int)(L >> 2), pn = (int)(L & 3), e = __builtin_amdgcn_readfirstlane(blke[pm * 32 + VZ]);
        u.row0 = pm * BM; u.col0 = pn * BM; u.B = W + (size_t)e * estride + (size_t)pn * BM * K * 2; u.rows = rows ? rows + pm * BM : nullptr; u.aoff = 0; return true;
    }
};

template <class Epi, class Sched>
__device__ __forceinline__ void gemm_phase(LAS unsigned char* lds, const void* gA_, const int K, const int lda, const int ldb, const Sched& S, const Epi& E) {
    const char* gA = (const char*)gA_;
    int tid = threadIdx.x; asm volatile("" : "+v"(tid));
    const int wid = __builtin_amdgcn_readfirstlane(tid >> 6), lane = tid & 63, wr = wid >> 2, wc = wid & 3, fr = lane & 15, fq = lane >> 4;
    const int nt = K / BK;
    unsigned voffB[2];
#pragma unroll
    for (int i = 0; i < 2; ++i) { int R, C; stage_rc(tid * 16 + i * 8192, R, C); const int Rb = (R & ~31) + perm32(R & 31); voffB[i] = (unsigned)(Rb * ldb + C) * 2u; }
    LAS u32x4* park = (LAS u32x4*)(lds + 131072 + 64) + tid;
    const size_t kstep = (size_t)(BK * 2);
    const size_t hstepA = 0; (void)hstepA; const size_t hstep = (size_t)HALF * ldb * 2;
    const unsigned ldsw = (unsigned)wid * 1024u;
    const int aoff = lds_byte(wr * 64 + fr, fq * 8), boff = lds_byte(wc * 32 + fr, fq * 8);
#define PG8_SA(b, h) (((b) * 2 + (h)) * HTB)
#define PG8_SB(b, h) ((4 + (b) * 2 + (h)) * HTB)
#define PG8_STAGE_B(bufoff, gbase) do { _Pragma("unroll") for (int _i = 0; _i < 2; ++_i) \
        __builtin_amdgcn_global_load_lds((const unsigned*)((const char*)(gbase) + voffB[_i]), (LAS unsigned*)(lds + (bufoff) + ldsw + _i * 8192), 16, 0, 0); } while (0)
#define PG8_STAGE_A(bufoff, vo, kb) do { _Pragma("unroll") for (int _i = 0; _i < 2; ++_i) \
        __builtin_amdgcn_global_load_lds((const unsigned*)(gA + (kb) + (vo(_i))), (LAS unsigned*)(lds + (bufoff) + ldsw + _i * 8192), 16, 0, 0); } while (0)
#define VC0(i) vc[0][i]
#define VC1(i) vc[1][i]
#define V20(i) vc[0][i]
#define V21(i) vc[1][i]
#define PG8_LDA(dst, b, h) do { _Pragma("unroll") for (int m = 0; m < 4; ++m) _Pragma("unroll") for (int k = 0; k < 2; ++k) dst[m][k] = *(const LAS bf16x8*)(lds + PG8_SA(b, h) + aoff + m * 2048 + k * 1024); } while (0)
#define PG8_LDB(dst, b, h) do { _Pragma("unroll") for (int n = 0; n < 2; ++n) _Pragma("unroll") for (int k = 0; k < 2; ++k) dst[n][k] = *(const LAS bf16x8*)(lds + PG8_SB(b, h) + boff + n * 2048 + k * 1024); } while (0)
#define PG8_MMA(ai, bj, At, Bt) do { __builtin_amdgcn_s_setprio(1); _Pragma("unroll") for (int m = 0; m < 4; ++m) _Pragma("unroll") for (int n = 0; n < 2; ++n) _Pragma("unroll") for (int k = 0; k < 2; ++k) \
        acc[ai][bj][m][n] = __builtin_amdgcn_mfma_f32_16x16x32_bf16(Bt[n][k], At[m][k], acc[ai][bj][m][n], 0, 0, 0); __builtin_amdgcn_s_setprio(0); } while (0)
#define PG8_WAIT_V(n) asm volatile("s_waitcnt vmcnt(" #n ")" ::: "memory")
#define PG8_WAIT_L(n) asm volatile("s_waitcnt lgkmcnt(" #n ")" ::: "memory")
#define PG8_BAR __builtin_amdgcn_s_barrier()
#define PG8_SCHED __builtin_amdgcn_sched_barrier(0)
#define PG8_MKVO(u, vo) do { _Pragma("unroll") for (int _h = 0; _h < 2; ++_h) _Pragma("unroll") for (int _i = 0; _i < 2; ++_i) { int _R, _C; stage_rc(tid * 16 + _i * 8192, _R, _C); const int _r = _h * HALF + _R; \
        int _row; if ((u).rows) { _row = (u).rows[_r]; _row = _row < 0 ? 0 : _row; } else _row = (u).row0 + _r; (vo)[_h][_i] = (unsigned)_row * (unsigned)(lda * 2) + (unsigned)(_C * 2) + (unsigned)(u).aoff; } } while (0)
    Unit cur, nxt; int ui = 0;
    if (!S.next(0, cur)) return;
    unsigned vc[2][2];
    PG8_MKVO(cur, vc);
    f32x4 acc[2][2][4][2];
#pragma unroll
    for (int a = 0; a < 2; ++a)
#pragma unroll
        for (int b = 0; b < 2; ++b)
#pragma unroll
            for (int m = 0; m < 4; ++m)
#pragma unroll
                for (int n = 0; n < 2; ++n) acc[a][b][m][n] = (f32x4){0.f, 0.f, 0.f, 0.f};
    bf16x8 At[4][2], B0[2][2], B1[2][2];
    const char* cB = cur.B;
    PG8_STAGE_B(PG8_SB(0, 0), cB); PG8_STAGE_B(PG8_SB(0, 1), cB + hstep); PG8_STAGE_A(PG8_SA(0, 0), VC0, 0); PG8_STAGE_A(PG8_SA(0, 1), VC1, 0);
    if (wr == 1) PG8_BAR;
    PG8_WAIT_V(2); PG8_BAR;
    PG8_STAGE_B(PG8_SB(1, 0), cB + kstep); PG8_STAGE_A(PG8_SA(1, 0), VC0, kstep); PG8_STAGE_B(PG8_SB(1, 1), cB + hstep + kstep);
    PG8_WAIT_V(6); PG8_BAR;
    for (;;) {
        const bool has_next = S.next(ui + 1, nxt);
        { unsigned vt[2][2];
          if (has_next) { PG8_MKVO(nxt, vt); } else { vt[0][0] = vc[0][0]; vt[0][1] = vc[0][1]; vt[1][0] = vc[1][0]; vt[1][1] = vc[1][1]; }
          *park = (u32x4){vt[0][0], vt[0][1], vt[1][0], vt[1][1]}; }
        const char* nB = has_next ? nxt.B : cB;
#pragma unroll 1
        for (int t = 0; t < nt; t += 2) {
            const bool last = (t == nt - 2);
            const size_t ka1 = (size_t)(t + 1) * kstep;
            const size_t k2 = last ? 0 : (size_t)(t + 2) * kstep, k3 = k2 + kstep;
            const char* b2 = last ? nB : cB + (size_t)(t + 2) * kstep; const char* b3 = b2 + kstep;
            PG8_LDB(B0, 0, 0); PG8_LDB(B1, 0, 1); PG8_SCHED; PG8_LDA(At, 0, 0); PG8_STAGE_A(PG8_SA(1, 1), VC1, ka1);
            if (last) { const u32x4 pv = *park; vc[0][0] = pv.x; vc[0][1] = pv.y; vc[1][0] = pv.z; vc[1][1] = pv.w; }
            PG8_WAIT_V(8); PG8_WAIT_L(0); PG8_BAR; PG8_MMA(0, 0, At, B0); PG8_MMA(0, 1, At, B1); PG8_BAR; PG8_SCHED;
            PG8_LDA(At, 0, 1); PG8_STAGE_B(PG8_SB(0, 0), b2); PG8_STAGE_B(PG8_SB(0, 1), b2 + hstep); PG8_STAGE_A(PG8_SA(0, 0), V20, k2);
            PG8_WAIT_V(8); PG8_WAIT_L(0); PG8_BAR; PG8_MMA(1, 0, At, B0); PG8_MMA(1, 1, At, B1); PG8_BAR; PG8_SCHED;
            PG8_LDB(B0, 1, 0); PG8_LDB(B1, 1, 1); PG8_SCHED; PG8_LDA(At, 1, 0); PG8_STAGE_A(PG8_SA(0, 1), V21, k2);
            PG8_WAIT_V(8); PG8_WAIT_L(0); PG8_BAR; PG8_MMA(0, 0, At, B0); PG8_MMA(0, 1, At, B1); PG8_BAR; PG8_SCHED;
            PG8_LDA(At, 1, 1); PG8_STAGE_B(PG8_SB(1, 0), b3); PG8_STAGE_B(PG8_SB(1, 1), b3 + hstep); PG8_STAGE_A(PG8_SA(1, 0), V20, k3);
            PG8_WAIT_V(8); PG8_WAIT_L(0); PG8_BAR; PG8_MMA(1, 0, At, B0); PG8_MMA(1, 1, At, B1); PG8_BAR; PG8_SCHED;
        }
        if (wr == 0) PG8_BAR;
        E(acc, cur, wr, wc, fr, fq);
        if (!has_next) break;
#pragma unroll
        for (int a = 0; a < 2; ++a)
#pragma unroll
            for (int b = 0; b < 2; ++b)
#pragma unroll
                for (int m = 0; m < 4; ++m)
#pragma unroll
                    for (int n = 0; n < 2; ++n) acc[a][b][m][n] = (f32x4){0.f, 0.f, 0.f, 0.f};
        cur = nxt; cB = nB; ++ui;
        if (wr == 1) PG8_BAR;
    }
    PG8_WAIT_V(0);
    PG8_BAR;
#undef PG8_SA
#undef PG8_SB
#undef PG8_STAGE_A
#undef PG8_STAGE_B
#undef PG8_LDA
#undef PG8_LDB
#undef PG8_MMA
#undef PG8_WAIT_V
#undef PG8_WAIT_L
#undef PG8_BAR
#undef PG8_SCHED
#undef PG8_MKVO
#undef VC0
#undef VC1
#undef V20
#undef V21
}
struct EpiProj {
    bf16_t* O; float* AB;
    __device__ __forceinline__ void operator()(const f32x4 (&acc)[2][2][4][2], const Unit& u, int wr, int wc, int fr, int fq) const {
#pragma unroll
        for (int ai = 0; ai < 2; ++ai)
#pragma unroll
            for (int m = 0; m < 4; ++m) { const int r = u.row0 + ai * HALF + wr * 64 + m * 16 + fr;
#pragma unroll
                for (int bj = 0; bj < 2; ++bj) { const int c = u.col0 + bj * HALF + wc * 32 + 8 * fq; const f32x4 v0 = acc[ai][bj][m][0], v1 = acc[ai][bj][m][1];
                    if (c < PJ) { u32x4 w; w.x = cvt_pk_bf16(v0[0], v0[1]); w.y = cvt_pk_bf16(v0[2], v0[3]); w.z = cvt_pk_bf16(v1[0], v1[1]); w.w = cvt_pk_bf16(v1[2], v1[3]); *(u32x4*)(O + (size_t)r * NPJ + c) = w; }
                    if (c >= 4 * GW && c < 4 * GW + 4 * GH) { *(f32x4*)(AB + (size_t)r * 32 + (c - 4 * GW)) = v0; *(f32x4*)(AB + (size_t)r * 32 + (c - 4 * GW) + 4) = v1; } } }
    }
};
template <bool FIRST> struct EpiResid {
    float* X; const float* g; const float* xl; const float* xc;
    __device__ __forceinline__ void operator()(const f32x4 (&acc)[2][2][4][2], const Unit& u, int wr, int wc, int fr, int fq) const {
#pragma unroll
        for (int ai = 0; ai < 2; ++ai)
#pragma unroll
            for (int m = 0; m < 4; ++m) { const int r = u.row0 + ai * HALF + wr * 64 + m * 16 + fr; const float* gr = g + (size_t)tok_modrow(r) * 6 * D;
#pragma unroll
                for (int bj = 0; bj < 2; ++bj)
#pragma unroll
                    for (int n = 0; n < 2; ++n) { const int c = u.col0 + bj * HALF + wc * 32 + 8 * fq + 4 * n; f32x4* xp = (f32x4*)(X + (size_t)r * D + c); const f32x4 gv = *(const f32x4*)(gr + c);
                        const f32x4 xin = FIRST ? *(const f32x4*)((r < NL ? xl + (size_t)r * D : xc + (size_t)(r - NL) * D) + c) : *xp; *xp = xin + gv * acc[ai][bj][m][n]; } }
    }
};
struct EpiAct {
    bf16_t* O;
    __device__ __forceinline__ void operator()(const f32x4 (&acc)[2][2][4][2], const Unit& u, int wr, int wc, int fr, int fq) const {
#pragma unroll
        for (int ai = 0; ai < 2; ++ai)
#pragma unroll
            for (int m = 0; m < 4; ++m) { const int r = u.row0 + ai * HALF + wr * 64 + m * 16 + fr;
#pragma unroll
                for (int bj = 0; bj < 2; ++bj) { const int c = u.col0 + bj * HALF + wc * 32 + 8 * fq; const f32x4 v0 = acc[ai][bj][m][0], v1 = acc[ai][bj][m][1];
                    u32x2 w; w.x = cvt_pk_bf16(siluf(v0[0]) * v0[1], siluf(v0[2]) * v0[3]); w.y = cvt_pk_bf16(siluf(v1[0]) * v1[1], siluf(v1[2]) * v1[3]);
                    *(u32x2*)(O + (size_t)r * HID + (c >> 1)) = w; } }
    }
};
struct EpiY {
    bf16_t* O;
    __device__ __forceinline__ void operator()(const f32x4 (&acc)[2][2][4][2], const Unit& u, int wr, int wc, int fr, int fq) const {
#pragma unroll
        for (int ai = 0; ai < 2; ++ai)
#pragma unroll
            for (int m = 0; m < 4; ++m) { const int r = u.row0 + ai * HALF + wr * 64 + m * 16 + fr;
#pragma unroll
                for (int bj = 0; bj < 2; ++bj) { const int c = u.col0 + bj * HALF + wc * 32 + 8 * fq; const f32x4 v0 = acc[ai][bj][m][0], v1 = acc[ai][bj][m][1];
                    u32x4 w; w.x = cvt_pk_bf16(v0[0], v0[1]); w.y = cvt_pk_bf16(v0[2], v0[3]); w.z = cvt_pk_bf16(v1[0], v1[1]); w.w = cvt_pk_bf16(v1[2], v1[3]); *(u32x4*)(O + (size_t)r * D + c) = w; } }
    }
};
}

__device__ __forceinline__ void transpose_tile(const float* src, int sN, int Nvalid, int k0, int n0, bf16_t* dst, int K, int rmul, int roff, LAS unsigned char* lds) {
    LAS bf16_t* T = (LAS bf16_t*)lds;
    int t = threadIdx.x; asm volatile("" : "+v"(t));
    { const int kk = t >> 3, c8 = (t & 7) * 8; const float* sp = src + (size_t)(k0 + kk) * sN + n0 + c8;
#pragma unroll
      for (int j = 0; j < 8; ++j) { const float v = (n0 + c8 + j) < Nvalid ? sp[j] : 0.f; T[(c8 + j) * 66 + kk] = f2bf(v); } }
    __syncthreads();
    { const int nn = t >> 3, k8 = (t & 7) * 8; const LAS unsigned* tp = (const LAS unsigned*)(T + nn * 66 + k8);
      pg8::u32x4 w; w.x = tp[0]; w.y = tp[1]; w.z = tp[2]; w.w = tp[3];
      *(pg8::u32x4*)(dst + (size_t)((n0 + nn) * rmul + roff) * K + k0 + k8) = w; }
    __syncthreads();
}
__device__ __forceinline__ void ph_wprep(const P& p, LAS unsigned char* lds) {
    const int G = gridDim.x, c = blockIdx.x;
    for (int it = c; it < DEPTH * (D / 64) * (NPJ / 64); it += G) { const int l = it / ((D / 64) * (NPJ / 64)), r = it % ((D / 64) * (NPJ / 64)), kt = r / (NPJ / 64), ntl = r % (NPJ / 64);
        transpose_tile(p.w_in + (size_t)l * D * PJ, PJ, PJ, kt * 64, ntl * 64, p.WinT + (size_t)l * NPJ * D, D, 1, 0, lds); }
    for (int it = c; it < DEPTH * (D / 64) * (D / 64); it += G) { const int l = it / ((D / 64) * (D / 64)), r = it % ((D / 64) * (D / 64)), kt = r / (D / 64), ntl = r % (D / 64);
        transpose_tile(p.w_out + (size_t)l * D * D, D, D, kt * 64, ntl * 64, p.WoutT + (size_t)l * D * D, D, 1, 0, lds); }
}
constexpr int MOE_T13 = NE * 2 * (D / 64) * (HID / 64), MOE_TILES = MOE_T13 + NE * (HID / 64) * (D / 64);
__device__ __forceinline__ void moe_tile(const P& p, int l, int t, LAS unsigned char* lds) {
    if (t < MOE_T13) { const int per = (D / 64) * (HID / 64), le = l * NE + t / (2 * per), r = t % (2 * per), s3 = r / per, q = r % per, kt = q / (HID / 64), ntl = q % (HID / 64);
        transpose_tile((s3 ? p.moe_w3 : p.moe_w1) + (size_t)le * D * HID, HID, HID, kt * 64, ntl * 64, p.W13T + (size_t)le * 2 * HID * D, D, 2, s3, lds); }
    else { const int t2 = t - MOE_T13, per = (HID / 64) * (D / 64), le = l * NE + t2 / per, q = t2 % per, kt = q / (D / 64), ntl = q % (D / 64);
        transpose_tile(p.moe_w2 + (size_t)le * HID * D, D, D, kt * 64, ntl * 64, p.W2T + (size_t)le * D * HID, HID, 1, 0, lds); }
}
__device__ __forceinline__ void moe_batch4(const P& p, int l, int t0, LAS unsigned char* lds) {
    typedef float f32x4 __attribute__((ext_vector_type(4)));
    int t = threadIdx.x; HIDE(t);
    const int kk = t >> 3, c8 = (t & 7) * 8;
    f32x4 v[4][2];
#pragma unroll
    for (int j = 0; j < 4; ++j) { const int tt = t0 + j; const float* sp;
        if (tt < MOE_T13) { const int per = (D / 64) * (HID / 64), le = l * NE + tt / (2 * per), r = tt % (2 * per), s3 = r / per, q = r % per, kt = q / (HID / 64), ntl = q % (HID / 64);
            sp = (s3 ? p.moe_w3 : p.moe_w1) + (size_t)le * D * HID + (size_t)(kt * 64 + kk) * HID + ntl * 64 + c8; }
        else { const int t2 = tt - MOE_T13, per = (HID / 64) * (D / 64), le = l * NE + t2 / per, q = t2 % per, kt = q / (D / 64), ntl = q % (D / 64);
            sp = p.moe_w2 + (size_t)le * HID * D + (size_t)(kt * 64 + kk) * D + ntl * 64 + c8; }
        v[j][0] = *(const f32x4*)sp; v[j][1] = *(const f32x4*)(sp + 4); }
#pragma unroll
    for (int j = 0; j < 4; ++j) { LAS bf16_t* T = (LAS bf16_t*)(lds + j * 8704);
#pragma unroll
        for (int i = 0; i < 8; ++i) T[(c8 + i) * 66 + kk] = f2bf(v[j][i >> 2][i & 3]); }
    __syncthreads();
    const int nn = t >> 3, k8 = (t & 7) * 8;
#pragma unroll
    for (int j = 0; j < 4; ++j) { const int tt = t0 + j; bf16_t* dp;
        if (tt < MOE_T13) { const int per = (D / 64) * (HID / 64), le = l * NE + tt / (2 * per), r = tt % (2 * per), s3 = r / per, q = r % per, kt = q / (HID / 64), ntl = q % (HID / 64);
            dp = p.W13T + (size_t)le * 2 * HID * D + (size_t)((ntl * 64 + nn) * 2 + s3) * D + kt * 64 + k8; }
        else { const int t2 = tt - MOE_T13, per = (HID / 64) * (D / 64), le = l * NE + t2 / per, q = t2 % per, kt = q / (D / 64), ntl = q % (D / 64);
            dp = p.W2T + (size_t)le * D * HID + (size_t)(ntl * 64 + nn) * HID + kt * 64 + k8; }
        const LAS unsigned* tp = (const LAS unsigned*)((LAS bf16_t*)(lds + j * 8704) + nn * 66 + k8);
        pg8::u32x4 w; w.x = tp[0]; w.y = tp[1]; w.z = tp[2]; w.w = tp[3];
        *(pg8::u32x4*)dp = w; }
    __syncthreads();
}
__device__ __forceinline__ void wq_pull(const P& p, int l, int nbatch, LAS unsigned char* lds) {
    if (l >= DEPTH) return;
    unsigned* ctr = p.bar + 3712 + l * 32; LAS int* tq = (LAS int*)(lds + 131072 + 48);
    for (int k = 0; nbatch < 0 || k < nbatch; ++k) {
        __syncthreads();
        if (threadIdx.x == 0) *tq = (int)__hip_atomic_fetch_add(ctr, 4u, __ATOMIC_RELAXED, __HIP_MEMORY_SCOPE_AGENT);
        __syncthreads();
        const int t0 = __builtin_amdgcn_readfirstlane(*tq); if (t0 >= MOE_TILES) break;
        moe_batch4(p, l, t0, lds);
    }
}
__device__ __forceinline__ void ph_inproj_mfma(const P& p, int l, LAS unsigned char* lds) {
    pg8::DenseSched S; S.init(NT, NPJ, D, p.WinT + (size_t)l * NPJ * D, gridDim.x, blockIdx.x);
    pg8::EpiProj E{p.PROJb, p.AB};
    pg8::gemm_phase(lds, p.HNb, D, D, D, S, E);
}
__device__ __forceinline__ void ph_outproj_mfma(const P& p, int l, int ntok, LAS unsigned char* lds) {
    pg8::DenseSched S; S.init(ntok, D, D, p.WoutT + (size_t)l * D * D, gridDim.x, blockIdx.x);
    if (l == 0) { pg8::EpiResid<true> E{p.X, p.MOD + (size_t)l * (NB + 1) * 6 * D + 2 * D, p.x, p.ctx}; pg8::gemm_phase(lds, p.MIXb, D, D, D, S, E); }
    else { pg8::EpiResid<false> E{p.X, p.MOD + (size_t)l * (NB + 1) * 6 * D + 2 * D, nullptr, nullptr}; pg8::gemm_phase(lds, p.MIXb, D, D, D, S, E); }
}
__device__ __forceinline__ void ph_moe1_mfma(const P& p, int l, LAS unsigned char* lds) {
    pg8::MoeSched S{(__builtin_amdgcn_readfirstlane(p.OFF[NE * 32 + VZ]) / MBLK) * 4, (int)gridDim.x, (int)blockIdx.x, (const char*)(p.W13T + (size_t)l * NE * 2 * HID * D), (size_t)2 * HID * D * 2, D, p.BLKE, p.SLOT_TOK};
    pg8::EpiAct E{p.ACTb};
    pg8::gemm_phase(lds, p.H2b, D, H2S, D, S, E);
}
__device__ __forceinline__ void ph_moe2_mfma(const P& p, int l, LAS unsigned char* lds) {
    pg8::MoeSched S{(__builtin_amdgcn_readfirstlane(p.OFF[NE * 32 + VZ]) / MBLK) * 4, (int)gridDim.x, (int)blockIdx.x, (const char*)(p.W2T + (size_t)l * NE * D * HID), (size_t)D * HID * 2, HID, p.BLKE, nullptr};
    pg8::EpiY E{p.Yb};
    pg8::gemm_phase(lds, p.ACTb, HID, HID, HID, S, E);
}

namespace att {
typedef short bf16x8 __attribute__((ext_vector_type(8)));
typedef float f32x16 __attribute__((ext_vector_type(16)));
typedef unsigned u32x4 __attribute__((ext_vector_type(4)));
typedef unsigned u32x2 __attribute__((ext_vector_type(2)));
constexpr int KROW = 144, VROW = 136, KBUF = 64 * KROW, VBUF = 64 * VROW, VOFF = 2 * KBUF;
typedef float f32x2_t __attribute__((ext_vector_type(2))); typedef __bf16 bf16x2_t __attribute__((ext_vector_type(2)));
__device__ __forceinline__ unsigned pk(float lo, float hi) { const f32x2_t v = {lo, hi}; return __builtin_bit_cast(unsigned, __builtin_convertvector(v, bf16x2_t)); }
__device__ __forceinline__ float ex2(float x) { return __builtin_amdgcn_exp2f(x); }
__device__ __forceinline__ float max3f(float a, float b, float c) { float r; asm("v_max3_f32 %0, %1, %2, %3" : "=v"(r) : "v"(a), "v"(b), "v"(c)); return r; }
}
__device__ __forceinline__ void ph_attn_mfma(const P& p, int l, bool need_ctx, LAS unsigned char* lds) {
    using namespace att;
    int tid = threadIdx.x; HIDE(tid);
    const int wid = __builtin_amdgcn_readfirstlane(tid >> 6), lane = tid & 63, r32 = lane & 31, hh = lane >> 5, g = wid >> 1, tsub = wid & 1;
    const int srow = tid >> 3, schunk = tid & 7;
    constexpr int NLU = NB * AKH * (SEQ / 64), NCU = NB * AKH * (CTX / 64);
    const int nunits = NLU + (need_ctx ? NCU : 0);
    unsigned* qctr = p.bar + 3584 + l * 32; LAS int* uq = (LAS int*)(lds + 131072 + 32);
    for (;;) {
        __syncthreads();
        if (threadIdx.x == 0) *uq = (int)__hip_atomic_fetch_add(qctr, 1u, __ATOMIC_RELAXED, __HIP_MEMORY_SCOPE_AGENT);
        __syncthreads();
        const int u = *uq; if (u >= nunits) break;
        int b, kvh, tok0, kk0, ntiles;
        if (u < NLU) { b = u / (AKH * (SEQ / 64)); kvh = (u / (SEQ / 64)) % AKH; tok0 = b * SEQ + (u % (SEQ / 64)) * 64; kk0 = 0; ntiles = KK / 64; }
        else { const int v = u - NLU; b = v / (AKH * (CTX / 64)); kvh = (v / (CTX / 64)) % AKH; tok0 = NL + b * CTX + (v % (CTX / 64)) * 64; kk0 = SEQ; ntiles = CTX / 64; }
        const int hq = kvh * AG + g, token = tok0 + tsub * 32 + r32;
        bf16x8 qf[4];
        { const bf16_t* qrow = p.AQb + (size_t)token * AW + hq * HD + hh * 8;
#pragma unroll
          for (int s = 0; s < 4; ++s) qf[s] = *(const bf16x8*)(qrow + s * 16); }
        f32x16 o0, o1;
#pragma unroll
        for (int i = 0; i < 16; ++i) { o0[i] = 0.f; o1[i] = 0.f; }
        float m = -1e30f, lsum = 0.f;
        const bf16_t* Kg = p.Kc + ((size_t)(b * AKH + kvh) * KK + kk0 + srow) * HD + schunk * 8;
        const bf16_t* Vg = p.Vt + ((size_t)(b * AKH + kvh) * HD + srow) * KK + kk0 + schunk * 8;
        u32x4 kA = *(const u32x4*)Kg, vA = *(const u32x4*)Vg, kB = *(const u32x4*)(Kg + (size_t)64 * HD), vB = *(const u32x4*)(Vg + 64);
#define ATT_STORE(kr, vr, buf) do { LAS unsigned char* kb_ = lds + (buf) * KBUF + srow * KROW + schunk * 16; LAS unsigned char* vb_ = lds + VOFF + (buf) * VBUF + srow * VROW + schunk * 16; \
            *(LAS u32x4*)kb_ = (kr); *(LAS u32x2*)vb_ = (u32x2){(vr).x, (vr).y}; *(LAS u32x2*)(vb_ + 8) = (u32x2){(vr).z, (vr).w}; } while (0)
        ATT_STORE(kA, vA, 0);
        __syncthreads();
#define ATT_TILE(cur) do { \
            LAS unsigned char* Kb = lds + cur * KBUF; LAS unsigned char* Vb = lds + VOFF + cur * VBUF; \
            f32x16 s0, s1; \
_Pragma("unroll") \
            for (int i = 0; i < 16; ++i) { s0[i] = 0.f; s1[i] = 0.f; } \
_Pragma("unroll") \
            for (int s = 0; s < 4; ++s) { \
                const bf16x8 a0 = *(const LAS bf16x8*)(Kb + r32 * KROW + s * 32 + hh * 16), a1 = *(const LAS bf16x8*)(Kb + (r32 + 32) * KROW + s * 32 + hh * 16); \
                s0 = __builtin_amdgcn_mfma_f32_32x32x16_bf16(a0, qf[s], s0, 0, 0, 0); \
                s1 = __builtin_amdgcn_mfma_f32_32x32x16_bf16(a1, qf[s], s1, 0, 0, 0); \
            } \
            float mx = max3f(s0[0], s1[0], s0[1]); \
_Pragma("unroll") \
            for (int i = 1; i < 15; ++i) mx = max3f(mx, s1[i], s0[i + 1]); \
            mx = max3f(mx, s1[15], __shfl_xor(max3f(mx, s1[15], s1[15]), 32)); \
            if (__ballot(mx > m + 8.0f) != 0ull) {        \
                const float mn = max3f(m, mx, mx), alpha = ex2(m - mn); m = mn; lsum *= alpha; \
_Pragma("unroll") \
                for (int i = 0; i < 16; ++i) { o0[i] *= alpha; o1[i] *= alpha; } \
            } \
            float rs = 0.f; \
_Pragma("unroll") \
            for (int i = 0; i < 16; ++i) { s0[i] = ex2(s0[i] - m); s1[i] = ex2(s1[i] - m); rs += s0[i] + s1[i]; } \
            lsum += rs; \
            bf16x8 pf[4]; \
_Pragma("unroll") \
            for (int s = 0; s < 2; ++s) { \
                u32x4 w0, w1; \
                w0.x = pk(s0[8 * s + 0], s0[8 * s + 1]); w0.y = pk(s0[8 * s + 2], s0[8 * s + 3]); w0.z = pk(s0[8 * s + 4], s0[8 * s + 5]); w0.w = pk(s0[8 * s + 6], s0[8 * s + 7]); \
                w1.x = pk(s1[8 * s + 0], s1[8 * s + 1]); w1.y = pk(s1[8 * s + 2], s1[8 * s + 3]); w1.z = pk(s1[8 * s + 4], s1[8 * s + 5]); w1.w = pk(s1[8 * s + 6], s1[8 * s + 7]); \
                pf[s] = __builtin_bit_cast(bf16x8, w0); pf[2 + s] = __builtin_bit_cast(bf16x8, w1); \
            } \
_Pragma("unroll") \
            for (int t = 0; t < 2; ++t) \
_Pragma("unroll") \
                for (int s = 0; s < 2; ++s) { \
                    const int kb2 = (32 * t + 16 * s + 4 * hh) * 2; \
                    const LAS unsigned char* v0p = Vb + r32 * VROW + kb2; const LAS unsigned char* v1p = Vb + (r32 + 32) * VROW + kb2; \
                    const u32x2 l0 = *(const LAS u32x2*)v0p, h0 = *(const LAS u32x2*)(v0p + 16), l1 = *(const LAS u32x2*)v1p, h1 = *(const LAS u32x2*)(v1p + 16); \
                    const bf16x8 av0 = __builtin_bit_cast(bf16x8, (u32x4){l0.x, l0.y, h0.x, h0.y}), av1 = __builtin_bit_cast(bf16x8, (u32x4){l1.x, l1.y, h1.x, h1.y}); \
                    o0 = __builtin_amdgcn_mfma_f32_32x32x16_bf16(av0, pf[2 * t + s], o0, 0, 0, 0); \
                    o1 = __builtin_amdgcn_mfma_f32_32x32x16_bf16(av1, pf[2 * t + s], o1, 0, 0, 0); \
                } \
        } while (0)
        static_assert((KK / 64) % 2 == 0 && (CTX / 64) % 2 == 0, "the tile loop is unrolled by two");
        for (int j = 0; j < ntiles; j += 2) {
            if (j + 2 < ntiles) { kA = *(const u32x4*)(Kg + (size_t)(j + 2) * 64 * HD); vA = *(const u32x4*)(Vg + (j + 2) * 64); }
            ATT_TILE(0);
            ATT_STORE(kB, vB, 1);
            __syncthreads();
            if (j + 3 < ntiles) { kB = *(const u32x4*)(Kg + (size_t)(j + 3) * 64 * HD); vB = *(const u32x4*)(Vg + (j + 3) * 64); }
            ATT_TILE(1);
            if (j + 2 < ntiles) ATT_STORE(kA, vA, 0);
            __syncthreads();
        }
#undef ATT_TILE
#undef ATT_STORE
        lsum += __shfl_xor(lsum, 32);
        const float inv = 1.0f / lsum;
        bf16_t* op = p.MIXb + (size_t)token * D + GW + LW + hq * HD + 4 * hh;
#pragma unroll
        for (int q = 0; q < 4; ++q) {
            *(u32x2*)(op + 8 * q) = (u32x2){pk(o0[4 * q] * inv, o0[4 * q + 1] * inv), pk(o0[4 * q + 2] * inv, o0[4 * q + 3] * inv)};
            *(u32x2*)(op + 32 + 8 * q) = (u32x2){pk(o1[4 * q] * inv, o1[4 * q + 1] * inv), pk(o1[4 * q + 2] * inv, o1[4 * q + 3] * inv)};
        }
    }
}
constexpr int NCP = NB * GH * 2 * NCH;
__device__ __forceinline__ int frag_off(int i, int k) { return ((((i >> 5) * 4 + (k >> 4)) * 64 + (((k >> 2) & 1) * 32 + (i & 31))) * 8) + ((k >> 3) & 1) * 4 + (k & 3); }
__device__ __forceinline__ att::bf16x8 cvt8(const float* q) {
    const pg8::f32x4 a = *(const pg8::f32x4*)q, b = *(const pg8::f32x4*)(q + 4);
    att::u32x4 w; w.x = att::pk(a[0], a[1]); w.y = att::pk(a[2], a[3]); w.z = att::pk(b[0], b[1]); w.w = att::pk(b[2], b[3]);
    return __builtin_bit_cast(att::bf16x8, w);
}
__device__ __forceinline__ att::bf16x8 pack8(const att::f32x16& v, int o) {
    att::u32x4 w; w.x = att::pk(v[o], v[o + 1]); w.y = att::pk(v[o + 2], v[o + 3]); w.z = att::pk(v[o + 4], v[o + 5]); w.w = att::pk(v[o + 6], v[o + 7]);
    return __builtin_bit_cast(att::bf16x8, w);
}
template <int I> __device__ __forceinline__ void gdn_solve_block(float (&x)[64], const LAS float* At) {
#pragma unroll
    for (int j = 0; j < 16 * I; ++j) {
        const LAS pg8::f32x4* ap = (const LAS pg8::f32x4*)(At + j * 64 + 16 * I);
        const float xj = x[j];
#pragma unroll
        for (int q = 0; q < 4; ++q) { const pg8::f32x4 a4 = ap[q]; x[16 * I + 4 * q] -= a4[0] * xj; x[16 * I + 4 * q + 1] -= a4[1] * xj; x[16 * I + 4 * q + 2] -= a4[2] * xj; x[16 * I + 4 * q + 3] -= a4[3] * xj; }
    }
#pragma unroll
    for (int r2 = 0; r2 < 15; ++r2) {
        const LAS pg8::f32x4* ap = (const LAS pg8::f32x4*)(At + (16 * I + r2) * 64 + 16 * I);
#pragma unroll
        for (int q = 0; q < 4; ++q) { if (4 * q + 3 > r2) { const pg8::f32x4 a4 = ap[q];
#pragma unroll
            for (int e = 0; e < 4; ++e) if (4 * q + e > r2) x[16 * I + 4 * q + e] -= a4[e] * x[16 * I + r2]; } }
    }
}
template <int PASS> __device__ __forceinline__ void gdn_pass(LAS float* At, const LAS int* nL, const LAS float* btL, const LAS float* egL, const bf16_t* colbase, float* Uo, bf16_t* Wo, int lane) {
    asm volatile("" ::: "memory");
    float x[64];
#pragma unroll
    for (int i = 0; i < 64; ++i) { const bf16_t* row = colbase + (size_t)nL[i] * 3 * GW; x[i] = PASS ? btL[i] * egL[i] * bf2f(row[GW]) : btL[i] * bf2f(row[2 * GW]); }
    gdn_solve_block<0>(x, At); gdn_solve_block<1>(x, At); gdn_solve_block<2>(x, At); gdn_solve_block<3>(x, At);
    const int r32 = lane & 31, hh = lane >> 5;
    if (PASS == 0) {
#pragma unroll
        for (int i = 0; i < 64; i += 4) { const int rr = i & 31;
            *(pg8::f32x4*)(Uo + (((i >> 5) * 2 + hh) * 64 + (((rr >> 2) & 1) * 32 + r32)) * 16 + 4 * (rr >> 3)) = (pg8::f32x4){x[i], x[i + 1], x[i + 2], x[i + 3]}; }
    } else {
        LAS bf16_t* T = (LAS bf16_t*)At;
#pragma unroll
        for (int i = 0; i < 64; ++i) T[frag_off(i, lane)] = f2bf(-x[i]);
#pragma unroll
        for (int c = 0; c < 8; ++c) *(pg8::u32x4*)(Wo + (c * 64 + lane) * 8) = *(const LAS pg8::u32x4*)(T + (c * 64 + lane) * 8);
    }
}
__device__ __forceinline__ void ph_gdn_a(const P& p, int l, LAS unsigned char* lds) {
    using namespace att;
    int tid = threadIdx.x; HIDE(tid);
    const int wid = __builtin_amdgcn_readfirstlane(tid >> 6);
    LAS float* At = (LAS float*)(lds + wid * 16384);
    LAS float* gcL = (LAS float*)(lds + 131072 + 64 + wid * 1024);
    LAS float* btL = gcL + 64; LAS float* egL = gcL + 128; LAS int* nL = (LAS int*)(gcL + 192);
    const int per_wg = (NCP + (int)gridDim.x - 1) / (int)gridDim.x;
    for (int q = wid; q < per_wg; q += 8) { const int cp = blockIdx.x * per_wg + q; if (cp >= NCP) break;
        int lane = tid & 63; HIDE(lane);
        const int r32 = lane & 31, hh = lane >> 5;
        const int ci = cp % NCH, dir = (cp / NCH) % 2, h = (cp / (2 * NCH)) % GH, b = cp / (2 * NCH * GH);
        const int n = chunk_tok(b, dir, ci, lane);
        const float bt = p.GB[(size_t)n * 2 * GH + dir * GH + h];
        float gc = p.GG[(size_t)n * 2 * GH + dir * GH + h];
#pragma unroll
        for (int off = 1; off < 64; off <<= 1) { const float t = __shfl_up(gc, off); if (lane >= off) gc += t; }
        const float gl = __shfl(gc, 63);
        gcL[lane] = gc; btL[lane] = bt; egL[lane] = fexp(gc); nL[lane] = n;
        bf16x8 kf[2][4], qf[2][4];
#pragma unroll
        for (int blk = 0; blk < 2; ++blk) { const int nr = __shfl(n, blk * 32 + r32); const bf16_t* base = (const bf16_t*)p.GQKV + (size_t)nr * 3 * GW + h * HD + 8 * hh;
#pragma unroll
            for (int s = 0; s < 4; ++s) { qf[blk][s] = *(const bf16x8*)(base + 16 * s); kf[blk][s] = *(const bf16x8*)(base + GW + 16 * s); } }
        bf16_t* QKo = p.GQK + (size_t)cp * 4096;
#pragma unroll
        for (int tl = 0; tl < 3; ++tl) {
            const int rb = tl > 0, cb = tl > 1;
            f32x16 ak, aq;
#pragma unroll
            for (int i = 0; i < 16; ++i) { ak[i] = 0.f; aq[i] = 0.f; }
#pragma unroll
            for (int s = 0; s < 4; ++s) { ak = __builtin_amdgcn_mfma_f32_32x32x16_bf16(kf[rb][s], kf[cb][s], ak, 0, 0, 0); aq = __builtin_amdgcn_mfma_f32_32x32x16_bf16(qf[rb][s], kf[cb][s], aq, 0, 0, 0); }
            const int j = cb * 32 + r32; const float gcj = gcL[j];
#pragma unroll
            for (int r = 0; r < 16; ++r) {
                const int i = rb * 32 + (r & 3) + 8 * (r >> 2) + 4 * hh;
                const float dec = fexp(j <= i ? gcL[i] - gcj : 0.f);
                At[j * 64 + i] = j < i ? btL[i] * ak[r] * dec : 0.f;
                QKo[frag_off(i, j)] = f2bf(j <= i ? aq[r] * dec : 0.f);
            }
        }
        float* Uo = p.GU + (size_t)cp * 4096; bf16_t* Wo = p.GWN + (size_t)cp * 4096; bf16_t* QGo = p.GQG + (size_t)cp * 4096; bf16_t* KTo = p.GKT + (size_t)cp * 4096;
        const bf16_t* colbase = (const bf16_t*)p.GQKV + h * HD + lane;
        gdn_pass<0>(At, nL, btL, egL, colbase, Uo, Wo, lane); gdn_pass<1>(At, nL, btL, egL, colbase, Uo, Wo, lane);
#pragma unroll 1
        for (int i0 = 0; i0 < 64; i0 += 16) {
            float qv[16], kv[16];
#pragma unroll
            for (int i = 0; i < 16; ++i) { const bf16_t* row = colbase + (size_t)nL[i0 + i] * 3 * GW; qv[i] = bf2f(row[0]); kv[i] = bf2f(row[GW]); }
#pragma unroll
            for (int i = 0; i < 16; ++i) { ((LAS bf16_t*)At)[frag_off(i0 + i, lane)] = f2bf(qv[i] * egL[i0 + i]); kv[i] *= fexp(gl - gcL[i0 + i]); }
#pragma unroll
            for (int i = 0; i < 16; i += 4) *(att::u32x2*)(KTo + frag_off(lane, i0 + i)) = (att::u32x2){att::pk(kv[i], kv[i + 1]), att::pk(kv[i + 2], kv[i + 3])};
        }
#pragma unroll
        for (int c = 0; c < 8; ++c) *(pg8::u32x4*)(QGo + (c * 64 + lane) * 8) = *(const LAS pg8::u32x4*)((LAS bf16_t*)At + (c * 64 + lane) * 8);
        if (lane == 0) p.GEL[(size_t)cp * 32] = fexp(gl);
    }
}
__device__ __forceinline__ void ph_gdn_b(const P& p, int l, LAS unsigned char* lds) {
    using namespace att;
    if (blockIdx.x >= NB * GH * 2 * 2) return;
    int tid = threadIdx.x; HIDE(tid);
    const int wid = __builtin_amdgcn_readfirstlane(tid >> 6), lane = tid & 63, r32 = lane & 31, hh = lane >> 5;
    const int wv = blockIdx.x, slice = wv & 1, pr = wv >> 1, dir = pr & 1, h = (pr >> 1) % GH, b = pr / (2 * GH);
    constexpr int SLOT = 40960;
#define GB_ISSUE(ci_, slot_) do { _Pragma("unroll") for (int i_ = 0; i_ < 6; ++i_) { int k_ = (wid - 1) * 6 + i_; k_ = k_ > 39 ? 39 : k_; \
        const size_t cp_ = (size_t)pr * NCH + (ci_); const char* g_; \
        if (k_ < 32) g_ = (const char*)((k_ < 8 ? p.GWN : k_ < 16 ? p.GQG : k_ < 24 ? p.GQK : p.GKT) + cp_ * 4096) + (size_t)(k_ & 7) * 1024 + lane * 16; \
        else g_ = (const char*)(p.GU + cp_ * 4096 + ((((k_ - 32) >> 2) * 2 + slice) * 64 + lane) * 16) + ((k_ - 32) & 3) * 16; \
        __builtin_amdgcn_global_load_lds((const unsigned*)g_, (LAS unsigned*)(lds + (slot_) * SLOT + k_ * 1024), 16, 0, 0); } } while (0)
    f32x16 S0, S1;
#pragma unroll
    for (int i = 0; i < 16; ++i) { S0[i] = 0.f; S1[i] = 0.f; }
    float ev = 0.f;
    if (wid == 0) { if (lane < NCH) ev = p.GEL[((size_t)pr * NCH + lane) * 32]; }
    else { GB_ISSUE(0, 0); GB_ISSUE(1, 1); asm volatile("s_waitcnt vmcnt(6)" ::: "memory"); }
    for (int ci = 0; ci < NCH; ++ci) {
        __builtin_amdgcn_s_barrier(); asm volatile("" ::: "memory");
        if (wid != 0) {
            if (ci + 2 < NCH) { const int sl = (ci + 2) % 3; GB_ISSUE(ci + 2, sl); asm volatile("s_waitcnt vmcnt(6)" ::: "memory"); }
            else asm volatile("s_waitcnt vmcnt(0)" ::: "memory");
            continue;
        }
        const LAS unsigned char* sb = lds + (ci % 3) * SLOT + lane * 16;
#define GB_FR(mat, idx) (*(const LAS bf16x8*)(sb + ((mat) * 8 + (idx)) * 1024))
        f32x16 x0, x1;
#pragma unroll
        for (int q = 0; q < 4; ++q) { const pg8::f32x4 a0 = *(const LAS pg8::f32x4*)(sb + (32 + q) * 1024), a1 = *(const LAS pg8::f32x4*)(sb + (36 + q) * 1024);
            x0[4 * q] = a0[0]; x0[4 * q + 1] = a0[1]; x0[4 * q + 2] = a0[2]; x0[4 * q + 3] = a0[3]; x1[4 * q] = a1[0]; x1[4 * q + 1] = a1[1]; x1[4 * q + 2] = a1[2]; x1[4 * q + 3] = a1[3]; }
        const float e = __builtin_bit_cast(float, __builtin_amdgcn_readlane(__builtin_bit_cast(int, ev), ci));
        bf16x8 sf[4]; sf[0] = pack8(S0, 0); sf[1] = pack8(S0, 8); sf[2] = pack8(S1, 0); sf[3] = pack8(S1, 8);
        f32x16 t0, t1;
#pragma unroll
        for (int i = 0; i < 16; ++i) { t0[i] = 0.f; t1[i] = 0.f; }
#pragma unroll
        for (int s2 = 0; s2 < 4; ++s2) {
            x0 = __builtin_amdgcn_mfma_f32_32x32x16_bf16(GB_FR(0, s2), sf[s2], x0, 0, 0, 0); x1 = __builtin_amdgcn_mfma_f32_32x32x16_bf16(GB_FR(0, 4 + s2), sf[s2], x1, 0, 0, 0);
            t0 = __builtin_amdgcn_mfma_f32_32x32x16_bf16(GB_FR(1, s2), sf[s2], t0, 0, 0, 0); t1 = __builtin_amdgcn_mfma_f32_32x32x16_bf16(GB_FR(1, 4 + s2), sf[s2], t1, 0, 0, 0);
        }
        bf16x8 xf[4]; xf[0] = pack8(x0, 0); xf[1] = pack8(x0, 8); xf[2] = pack8(x1, 0); xf[3] = pack8(x1, 8);
        t0 = __builtin_amdgcn_mfma_f32_32x32x16_bf16(GB_FR(2, 0), xf[0], t0, 0, 0, 0); t0 = __builtin_amdgcn_mfma_f32_32x32x16_bf16(GB_FR(2, 1), xf[1], t0, 0, 0, 0);
#pragma unroll
        for (int s2 = 0; s2 < 4; ++s2) t1 = __builtin_amdgcn_mfma_f32_32x32x16_bf16(GB_FR(2, 4 + s2), xf[s2], t1, 0, 0, 0);
#pragma unroll
        for (int i = 0; i < 16; ++i) { S0[i] *= e; S1[i] *= e; }
#pragma unroll
        for (int s2 = 0; s2 < 4; ++s2) { S0 = __builtin_amdgcn_mfma_f32_32x32x16_bf16(GB_FR(3, s2), xf[s2], S0, 0, 0, 0); S1 = __builtin_amdgcn_mfma_f32_32x32x16_bf16(GB_FR(3, 4 + s2), xf[s2], S1, 0, 0, 0); }
        float* go = p.GO + (size_t)dir * NT * GW + h * HD + slice * 32 + r32;
#pragma unroll
        for (int r = 0; r < 16; ++r) {
            const int c = (r & 3) + 8 * (r >> 2) + 4 * hh;
            go[(size_t)chunk_tok(b, dir, ci, c) * GW] = t0[r]; go[(size_t)chunk_tok(b, dir, ci, 32 + c) * GW] = t1[r];
        }
    }
    __builtin_amdgcn_s_barrier(); asm volatile("" ::: "memory");
#undef GB_ISSUE
#undef GB_FR
}
__device__ __forceinline__ pg8::f32x4 ldb4(const bf16_t* q) { const pg8::u32x2 w = *(const pg8::u32x2*)q; return (pg8::f32x4){__builtin_bit_cast(float, w.x << 16), __builtin_bit_cast(float, w.x & 0xffff0000u), __builtin_bit_cast(float, w.y << 16), __builtin_bit_cast(float, w.y & 0xffff0000u)}; }
__device__ __forceinline__ float wave_sum(float v) {
#pragma unroll
    for (int o = 32; o > 0; o >>= 1) v += __shfl_xor(v, o);
    return v;
}
__device__ __forceinline__ void ph_rownorm(const P& p, int l, int lc, int ntok_c, int nrows) {
    typedef float f32x4 __attribute__((ext_vector_type(4)));
    typedef unsigned u32x2 __attribute__((ext_vector_type(2)));
    int tid = threadIdx.x; HIDE(tid);
    const int lane = tid & 63, wave = blockIdx.x * 8 + (tid >> 6), nwaves = gridDim.x * 8;
    constexpr int R = 3;
    for (int nb = wave * R; nb < nrows; nb += nwaves * R) {
        f32x4 x[R][D / 256], ya[R][D / 256], yb[R][D / 256]; float g0[R], g1[R]; bool comb[R]; int mr[R];
#pragma unroll
        for (int r = 0; r < R; ++r) { const int n = nb + r < nrows ? nb + r : nrows - 1; mr[r] = tok_modrow(n); comb[r] = lc >= 0 && n < ntok_c;
#pragma unroll
            for (int j = 0; j < D / 256; ++j) x[r][j] = *(const f32x4*)((lc < 0 ? (n < NL ? p.x + (size_t)n * D : p.ctx + (size_t)(n - NL) * D) : p.X + (size_t)n * D) + j * 256 + lane * 4); }
        int s0[R], s1[R];
#pragma unroll
        for (int r = 0; r < R; ++r) { const int n = nb + r < nrows ? nb + r : nrows - 1; const int vz = VZ;
            if (comb[r]) { s0[r] = p.SLOT_OF[(size_t)n * 64 + vz]; s1[r] = p.SLOT_OF[(size_t)n * 64 + 32 + vz]; g0[r] = p.RG[n * 2 + vz]; g1[r] = p.RG[n * 2 + 1 + vz]; } else { s0[r] = 0; s1[r] = 0; g0[r] = 0.f; g1[r] = 0.f; } }
#pragma unroll
        for (int r = 0; r < R; ++r)
#pragma unroll
            for (int j = 0; j < D / 256; ++j) { const int o = j * 256 + lane * 4; if (comb[r]) { ya[r][j] = ldb4(p.Yb + (size_t)s0[r] * D + o); yb[r][j] = ldb4(p.Yb + (size_t)s1[r] * D + o); } else { ya[r][j] = (f32x4){0.f, 0.f, 0.f, 0.f}; yb[r][j] = ya[r][j]; } }
#pragma unroll
        for (int r = 0; r < R; ++r) {
            const int n = nb + r; if (n >= nrows) break;
            if (comb[r]) { const float* g2 = p.MOD + ((size_t)lc * (NB + 1) + mr[r]) * 6 * D + 5 * D;
#pragma unroll
                for (int j = 0; j < D / 256; ++j) { const int o = j * 256 + lane * 4; const f32x4 g = *(const f32x4*)(g2 + o); x[r][j] = x[r][j] + g * (ya[r][j] * g0[r] + yb[r][j] * g1[r]); if (l < DEPTH) *(f32x4*)(p.X + (size_t)n * D + o) = x[r][j]; } }
            float ss = 0.f;
#pragma unroll
            for (int j = 0; j < D / 256; ++j) ss += x[r][j][0] * x[r][j][0] + x[r][j][1] * x[r][j][1] + x[r][j][2] * x[r][j][2] + x[r][j][3] * x[r][j][3];
            const float rs = frsq(wave_sum(ss) * (1.0f / D) + EPS);
            if (l < DEPTH) {
                const float* gn = p.norm1_g + l * D; const float* md = p.MOD + ((size_t)l * (NB + 1) + mr[r]) * 6 * D;
#pragma unroll
                for (int j = 0; j < D / 256; ++j) { const int o = j * 256 + lane * 4; const f32x4 g = *(const f32x4*)(gn + o), sh = *(const f32x4*)(md + o), sc = *(const f32x4*)(md + D + o);
                    const f32x4 h = x[r][j] * rs * g * (sc + 1.0f) + sh;
                    *(u32x2*)(p.HNb + (size_t)n * D + o) = (u32x2){att::pk(h[0], h[1]), att::pk(h[2], h[3])}; }
            } else {
#pragma unroll
                for (int j = 0; j < D / 256; ++j) { const int o = j * 256 + lane * 4; const f32x4 g = *(const f32x4*)(p.final_norm_g + o); *(f32x4*)(p.out + (size_t)n * D + o) = x[r][j] * rs * g; }
            }
        }
    }
}
constexpr int MOD_KS = 8;
__device__ __forceinline__ void ph_mod_part(const P& p, LAS unsigned char* lds) {
    int tid = threadIdx.x; HIDE(tid);
    LAS float* SL = (LAS float*)lds;
    for (int i = tid; i < (NB + 1) * D; i += 512) { const int r = i / D, k = i % D; SL[i] = siluf(r < NB ? p.c[r * D + k] : p.c_ctx[k]); }
    __syncthreads();
    for (int it = blockIdx.x * 512 + tid; it < DEPTH * MOD_KS * 6 * D; it += gridDim.x * 512) {
        const int j = it % (6 * D), ks = (it / (6 * D)) % MOD_KS, l = it / (6 * D * MOD_KS);
        float acc[NB + 1];
#pragma unroll
        for (int r = 0; r <= NB; ++r) acc[r] = 0.f;
        const float* w = p.w_ada + ((size_t)l * D + ks * (D / MOD_KS)) * 6 * D + j;
#pragma unroll 8
        for (int k = 0; k < D / MOD_KS; ++k) { const float wv = w[(size_t)k * 6 * D];
#pragma unroll
            for (int r = 0; r <= NB; ++r) acc[r] += SL[r * D + ks * (D / MOD_KS) + k] * wv; }
#pragma unroll
        for (int r = 0; r <= NB; ++r) p.PART[(((size_t)ks * DEPTH + l) * (NB + 1) + r) * 6 * D + j] = acc[r];
    }
    __syncthreads();
}
__device__ __forceinline__ void ph_mod_reduce(const P& p) {
    int tid = threadIdx.x; HIDE(tid);
    for (int it = blockIdx.x * 512 + tid; it < DEPTH * (NB + 1) * 6 * D; it += gridDim.x * 512) {
        const int j = it % (6 * D), l = it / (6 * D * (NB + 1));
        float a = p.b_ada[l * 6 * D + j];
#pragma unroll
        for (int ks = 0; ks < MOD_KS; ++ks) a += p.PART[(size_t)ks * DEPTH * (NB + 1) * 6 * D + it];
        p.MOD[it] = a;
    }
}
__device__ __forceinline__ void ph_norm2_w(const P& p, int l, int ntok) {
    typedef float f32x4 __attribute__((ext_vector_type(4)));
    typedef unsigned u32x2 __attribute__((ext_vector_type(2)));
    int tid = threadIdx.x; HIDE(tid);
    const int lane = tid & 63, wave = blockIdx.x * 8 + (tid >> 6), nwaves = gridDim.x * 8;
    constexpr int R = 3;
    for (int nb = wave * R; nb < ntok; nb += nwaves * R) {
        f32x4 x[R][D / 256];
#pragma unroll
        for (int r = 0; r < R; ++r) { const int n = nb + r < ntok ? nb + r : ntok - 1;
#pragma unroll
            for (int j = 0; j < D / 256; ++j) x[r][j] = *(const f32x4*)(p.X + (size_t)n * D + j * 256 + lane * 4); }
#pragma unroll
        for (int r = 0; r < R; ++r) {
            const int n = nb + r; if (n >= ntok) break;
            float ss = 0.f;
#pragma unroll
            for (int j = 0; j < D / 256; ++j) ss += x[r][j][0] * x[r][j][0] + x[r][j][1] * x[r][j][1] + x[r][j][2] * x[r][j][2] + x[r][j][3] * x[r][j][3];
            const float rs = frsq(wave_sum(ss) * (1.0f / D) + EPS);
            const float* gn = p.norm2_g + l * D; const float* md = p.MOD + ((size_t)l * (NB + 1) + tok_modrow(n)) * 6 * D + 3 * D;
            bf16_t* hb = p.H2b + (size_t)n * H2S;
#pragma unroll
            for (int j = 0; j < D / 256; ++j) { const int o = j * 256 + lane * 4; const f32x4 g = *(const f32x4*)(gn + o), sh = *(const f32x4*)(md + o), sc = *(const f32x4*)(md + D + o);
                const f32x4 h = x[r][j] * rs * g * (sc + 1.0f) + sh;
                const u32x2 hi = (u32x2){att::pk(h[0], h[1]), att::pk(h[2], h[3])};
                const float r0 = h[0] - __builtin_bit_cast(float, hi.x << 16), r1 = h[1] - __builtin_bit_cast(float, hi.x & 0xffff0000u), r2 = h[2] - __builtin_bit_cast(float, hi.y << 16), r3 = h[3] - __builtin_bit_cast(float, hi.y & 0xffff0000u);
                const u32x2 lo = (u32x2){att::pk(r0, r1), att::pk(r2, r3)};
                *(u32x2*)(hb + o) = hi; *(u32x2*)(hb + D + o) = lo; }
        }
    }
}
__device__ __forceinline__ void ph_wr_prep(const P& p) {
    int tid = threadIdx.x; HIDE(tid);
    for (int it = blockIdx.x * 512 + tid; it < DEPTH * 256 * D; it += gridDim.x * 512) {
        const int k = it % D, j = (it / D) % 256, l = it / (D * 256);
        float w = 0.f; if (j < NG) w = p.moe_w_group[((size_t)l * D + k) * NG + j]; else if (j < NLOG) w = p.moe_w_expert[((size_t)l * D + k) * NE + (j - NG)];
        const bf16_t hi = f2bf(w), lo = f2bf(w - bf2f(hi));
        bf16_t* o = p.WrT + ((size_t)l * 256 + j) * H2S + k; o[0] = hi; o[D] = hi; o[2 * D] = lo;
    }
}
namespace pg8 {
struct EpiLogit {
    float* O;
    __device__ __forceinline__ void operator()(const f32x4 (&acc)[2][2][4][2], const Unit& u, int wr, int wc, int fr, int fq) const {
#pragma unroll
        for (int ai = 0; ai < 2; ++ai)
#pragma unroll
            for (int m = 0; m < 4; ++m) { const int r = u.row0 + ai * HALF + wr * 64 + m * 16 + fr;
#pragma unroll
                for (int n = 0; n < 2; ++n) { const int c = wc * 32 + 8 * fq + 4 * n; if (c < NLOG) *(f32x4*)(O + (size_t)r * 128 + c) = acc[ai][0][m][n]; } }
    }
};
}
namespace pg8 {
struct RouteSched {
    int nunits, G, c; const char* Bt;
    __device__ bool next(int i, Unit& u) const {
        const long L = (long)i * G + c; if (L >= nunits) return false;
        const int pm = (int)(L / 3), part = (int)(L % 3);
        u.row0 = pm * BM; u.col0 = part; u.B = Bt + (size_t)part * D * 2; u.rows = nullptr; u.aoff = (part == 2 ? 0 : part) * D * 2; return true;
    }
};
struct EpiLogitP {
    float* O;
    __device__ __forceinline__ void operator()(const f32x4 (&acc)[2][2][4][2], const Unit& u, int wr, int wc, int fr, int fq) const {
        float* Op = O + (size_t)u.col0 * NT * 128;
#pragma unroll
        for (int ai = 0; ai < 2; ++ai)
#pragma unroll
            for (int m = 0; m < 4; ++m) { const int r = u.row0 + ai * HALF + wr * 64 + m * 16 + fr;
#pragma unroll
                for (int n = 0; n < 2; ++n) { const int c = wc * 32 + 8 * fq + 4 * n; if (c < NLOG) *(f32x4*)(Op + (size_t)r * 128 + c) = acc[ai][0][m][n]; } }
    }
};
}
__device__ __forceinline__ void ph_rgemm(const P& p, int l, int ntok, LAS unsigned char* lds) {
    pg8::RouteSched S{(ntok / 256) * 3, (int)gridDim.x, (int)blockIdx.x, (const char*)(p.WrT + (size_t)l * 256 * H2S)};
    pg8::EpiLogitP E{p.LOGIT};
    pg8::gemm_phase(lds, p.H2b, D, H2S, H2S, S, E);
}
__device__ __forceinline__ void ph_topk(const P& p, int l, int ntok, LAS unsigned char* lds) {
    int tid = threadIdx.x; HIDE(tid);
    LAS int* hist = (LAS int*)lds;
    if (tid < NE) hist[tid] = 0;
    __syncthreads();
    for (int chunk = blockIdx.x + (tid >> 6) * gridDim.x; chunk * 64 < ntok; chunk += 8 * gridDim.x) { const int n = chunk * 64 + (tid & 63);
    if (n < ntok) {
        const float* lg = p.LOGIT + (size_t)n * 128; const float* lg1 = lg + (size_t)NT * 128; const float* lg2 = lg1 + (size_t)NT * 128;
        float g[NG]; int gi = 0;
#pragma unroll
        for (int j = 0; j < NG; ++j) g[j] = ((lg[j] + lg1[j]) + lg2[j]) + p.moe_b_group[l * NG + j];
        float gm = g[0];
#pragma unroll
        for (int j = 1; j < NG; ++j) if (g[j] > gm) { gm = g[j]; gi = j; }
        float gs = 0.f;
#pragma unroll
        for (int j = 0; j < NG; ++j) gs += fexp(g[j] - gm);
        float e1 = -1e30f, e2 = -1e30f; int i1 = 0, i2 = 0;
#pragma unroll
        for (int j = 0; j < EPG; ++j) { const float v = ((lg[NG + gi * EPG + j] + lg1[NG + gi * EPG + j]) + lg2[NG + gi * EPG + j]) + p.moe_b_expert[l * NE + gi * EPG + j]; if (v > e1) { e2 = e1; i2 = i1; e1 = v; i1 = j; } else if (v > e2) { e2 = v; i2 = j; } }
        const float w2 = fexp(e2 - e1), inv = 1.f / (1.f + w2), pg = 1.f / gs;
        const int ex0 = gi * EPG + i1, ex1 = gi * EPG + i2;
        p.RE[n * 2] = ex0; p.RE[n * 2 + 1] = ex1; p.RG[n * 2] = pg * inv; p.RG[n * 2 + 1] = pg * w2 * inv;
        __hip_atomic_fetch_add(hist + ex0, 1, __ATOMIC_RELAXED, __HIP_MEMORY_SCOPE_WORKGROUP); __hip_atomic_fetch_add(hist + ex1, 1, __ATOMIC_RELAXED, __HIP_MEMORY_SCOPE_WORKGROUP);
    } }
    __syncthreads();
    if (tid < NE) { const int c = hist[tid]; if (c) atomicAdd(&p.CNT[tid], c); }
    __syncthreads();
}
__device__ __forceinline__ void ph_slots_off_w(const P& p, int ntok) {
    int tid = threadIdx.x; HIDE(tid);
    const int lane = tid & 63, e = blockIdx.x * 8 + (tid >> 6);
    if (e >= NE) return;
    const int padl = (p.CNT[lane] + MBLK - 1) / MBLK * MBLK;
    int incl = padl;
#pragma unroll
    for (int o = 1; o < 64; o <<= 1) { const int t = __shfl_up(incl, o); if (lane >= o) incl += t; }
    const int total = __shfl(incl, 63), end = __shfl(incl, e), off = end - __shfl(padl, e);
    if (lane == 0) { p.OFF[e * 32] = off; if (e == NE - 1) p.OFF[NE * 32] = total; }
    for (int b = off / MBLK + lane; b < end / MBLK; b += 64) p.BLKE[b * 32] = e;
    if (e == NE - 1) for (int b = total / MBLK + lane; b < NBLK; b += 64) p.BLKE[b * 32] = -1;
    int run = 0;
    for (int base = 0; base < ntok * 2; base += 512) {
        int ex[8];
#pragma unroll
        for (int q = 0; q < 8; ++q) ex[q] = p.RE[base + q * 64 + lane];
#pragma unroll
        for (int q = 0; q < 8; ++q) {
            const int i = base + q * 64 + lane; const bool m = ex[q] == e;
            const unsigned long long mask = __ballot(m);
            if (m) { const int s2 = off + run + __popcll(mask & ((1ull << lane) - 1ull)); p.SLOT_TOK[s2] = i >> 1; p.SLOT_OF[(size_t)i * 32] = s2; }
            run += __popcll(mask);
        }
    }
    for (int s2 = off + run + lane; s2 < end; s2 += 64) p.SLOT_TOK[s2] = -1;
}
__device__ __forceinline__ void ph_wl_prep(const P& p) {
    int tid = threadIdx.x; HIDE(tid);
    for (int it = blockIdx.x * 512 + tid; it < DEPTH * 4 * LW * LW; it += gridDim.x * 512) {
        const int k = it % LW, nn = (it / LW) % (4 * LW), l = it / (LW * 4 * LW);
        const int dir = nn / (2 * LW), c = (nn % (2 * LW)) >> 1, gate = nn & 1;
        float w = 0.f;
        if (k / LBW == c / LBW) w = (gate ? p.lru_w_i : p.lru_w_r)[(((size_t)(l * 2 + dir) * 4 + c / LBW) * LBW + k % LBW) * LBW + c % LBW];
        p.WlT[it] = f2bf(w);
    }
}
namespace pg8 {
struct EpiLru {
    float* LA; float* LBX;
    __device__ __forceinline__ void operator()(const f32x4 (&acc)[2][2][4][2], const Unit& u, int wr, int wc, int fr, int fq) const {
#pragma unroll
        for (int bj = 0; bj < 2; ++bj) {
            const int col = u.col0 + bj * HALF + wc * 32 + 8 * fq, dir = col / (2 * LW), c0 = (col % (2 * LW)) >> 1;
#pragma unroll
            for (int ai = 0; ai < 2; ++ai)
#pragma unroll
                for (int m = 0; m < 4; ++m) { const int r = u.row0 + ai * HALF + wr * 64 + m * 16 + fr;
                    const f32x4 v0 = acc[ai][bj][m][0], v1 = acc[ai][bj][m][1];
                    *(u32x2*)((bf16_t*)LA + ((size_t)dir * NT + r) * LW + c0) = (u32x2){cvt_pk_bf16(v0[0], v0[2]), cvt_pk_bf16(v1[0], v1[2])}; *(u32x2*)((bf16_t*)LBX + ((size_t)dir * NT + r) * LW + c0) = (u32x2){cvt_pk_bf16(v0[1], v0[3]), cvt_pk_bf16(v1[1], v1[3])}; }
        }
    }
};
}
__device__ __forceinline__ void ph_lru_gates(const P& p, int l, LAS unsigned char* lds) {
    pg8::DenseSched S; S.init(NT, 4 * LW, LW, p.WlT + (size_t)l * 4 * LW * LW, gridDim.x, blockIdx.x);
    pg8::EpiLru E{p.LA, p.LBX};
    pg8::gemm_phase(lds, p.LXRb, LW, LW, LW, S, E);
}
__device__ __forceinline__ void ph_lru_scan(const P& p, int l) {
    int tid = threadIdx.x; HIDE(tid);
    if (tid < 64) return;
    bf16_t* LHb = (bf16_t*)p.LH; bf16_t* LAb = LHb + (size_t)2 * NT * LW;
    for (int it = blockIdx.x * 448 + (tid - 64); it < NB * 2 * NCH * LW; it += gridDim.x * 448) {
        const int c = it % LW, ci = (it / LW) % NCH, dir = (it / (LW * NCH)) % 2, b = it / (LW * NCH * 2);
        const float br = p.lru_b_r[(l * 2 + dir) * LW + c], bi = p.lru_b_i[(l * 2 + dir) * LW + c], sp = -8.0f * softplusf(-p.lru_lambda[(l * 2 + dir) * LW + c]);
        float h = 0.f, A = 1.f;
        for (int i0 = 0; i0 < 64; i0 += 16) {
            float pa[16], pb[16], px[16]; size_t ixs[16];
#pragma unroll
            for (int i = 0; i < 16; ++i) { const int n = chunk_tok(b, dir, ci, i0 + i); ixs[i] = ((size_t)dir * NT + n) * LW + c; pa[i] = bf2f(((const bf16_t*)p.LA)[ixs[i]]); pb[i] = bf2f(((const bf16_t*)p.LBX)[ixs[i]]); px[i] = bf2f(p.LXRb[(size_t)n * LW + c]); }
#pragma unroll
            for (int i = 0; i < 16; ++i) {
                const float la = sigmoidf(pa[i] + br) * sp, a = fexp(la), bx = __builtin_amdgcn_sqrtf(neg_expm1f(2.0f * la)) * (sigmoidf(pb[i] + bi) * px[i]);
                h = a * h + bx; A *= a; LHb[ixs[i]] = f2bf(h); LAb[ixs[i]] = f2bf(A);
            }
        }
    }
}
__device__ __forceinline__ void ph_prep_w(const P& p, int l) {
    typedef float f32x4 __attribute__((ext_vector_type(4)));
    typedef unsigned u32x2 __attribute__((ext_vector_type(2)));
    typedef unsigned u32x4 __attribute__((ext_vector_type(4)));
    int tid = threadIdx.x; HIDE(tid);
    const int lane = tid & 63, wave = blockIdx.x * 8 + (tid >> 6), nwaves = gridDim.x * 8;
    for (int n = wave; n < NT; n += nwaves) {
        int s0, len; tok_seg(n, s0, len);
        const bf16_t* pr = p.PROJb + (size_t)n * NPJ;
        f32x4 vq[3];
#pragma unroll
        for (int which = 0; which < 3; ++which) {
            const int c0 = which * GW + lane * 4;
            const float* w = p.gdn_conv_w + (size_t)l * 4 * 3 * GW + c0;
            f32x4 acc = (f32x4){0.f, 0.f, 0.f, 0.f};
#pragma unroll
            for (int j = 0; j < 4; ++j) { const int m = n + j - 1; if (m >= s0 && m < s0 + len) acc = acc + *(const f32x4*)(w + j * 3 * GW) * ldb4(p.PROJb + (size_t)m * NPJ + c0); }
            f32x4 v; v[0] = siluf(acc[0]); v[1] = siluf(acc[1]); v[2] = siluf(acc[2]); v[3] = siluf(acc[3]);
            if (which < 2) {
                float ss = v[0] * v[0] + v[1] * v[1] + v[2] * v[2] + v[3] * v[3];
                ss += __shfl_xor(ss, 1); ss += __shfl_xor(ss, 2); ss += __shfl_xor(ss, 4); ss += __shfl_xor(ss, 8);
                v = v * (frsq(ss + EPS) * (which == 0 ? 0.125f : 1.0f));
            }
            vq[which] = v;
        }
        const int lg = lane & (2 * GH - 1);
        const float al = p.AB[(size_t)n * 32 + lg], be = p.AB[(size_t)n * 32 + 2 * GH + lg];
        const float gg = -fexp(p.gdn_a_log[l * 2 * GH + lg]) * softplusf(al + p.gdn_dt_bias[l * 2 * GH + lg]), gb = sigmoidf(be);
        f32x4 lacc;
        {
            const int c0 = lane * 4; const float* w = p.lru_conv_w + (size_t)l * 4 * LW + c0;
            f32x4 acc = *(const f32x4*)(p.lru_conv_b + l * LW + c0);
#pragma unroll
            for (int j = 0; j < 4; ++j) { const int m = n + j - 1; if (m >= s0 && m < s0 + len) acc = acc + *(const f32x4*)(w + j * LW) * ldb4(p.PROJb + (size_t)m * NPJ + O_L + c0); }
            lacc = acc;
        }
        const int b = n < NL ? n / SEQ : (n - NL) / CTX, kk = n < NL ? n % SEQ : SEQ + (n - NL) % CTX;
        const float* rt = p.ROPE + (size_t)(n < NL ? n % SEQ : 0) * 64;
        u32x4 wqk[2];
#pragma unroll
        for (int isk = 0; isk < 2; ++isk) {
            const int ls = isk ? (lane & 15) : lane, d0 = (ls & 7) * 8;
            const bf16_t* src = pr + O_A + (isk ? AW : 0) + ls * 8; const float* g = (isk ? p.attn_k_norm_g : p.attn_q_norm_g) + l * HD + d0;
            const f32x4 a0 = ldb4(src), a1 = ldb4(src + 4);
            float x[8] = {a0[0], a0[1], a0[2], a0[3], a1[0], a1[1], a1[2], a1[3]};
            float ss = 0.f;
#pragma unroll
            for (int e = 0; e < 8; ++e) ss += x[e] * x[e];
            ss += __shfl_xor(ss, 1); ss += __shfl_xor(ss, 2); ss += __shfl_xor(ss, 4);
            const float rs = frsq(ss * (1.0f / HD) + EPS);
#pragma unroll
            for (int e = 0; e < 8; ++e) x[e] = x[e] * rs * g[e];
            if (n < NL) {
                const int second = (ls >> 1) & 1, half = (ls >> 2) & 1, i0 = (ls & 1) * 8;
#pragma unroll
                for (int e = 0; e < 8; ++e) { const float other = __shfl_xor(x[e], 2), cs = rt[half * 32 + i0 + e], sn = rt[half * 32 + 16 + i0 + e];
                    x[e] = second ? other * sn + x[e] * cs : x[e] * cs - other * sn; }
            }
            const float qs = isk ? 1.0f : QSCALE;
            wqk[isk] = (u32x4){att::pk(x[0] * qs, x[1] * qs), att::pk(x[2] * qs, x[3] * qs), att::pk(x[4] * qs, x[5] * qs), att::pk(x[6] * qs, x[7] * qs)};
        }
#pragma unroll
        for (int which = 0; which < 3; ++which) *(u32x2*)((bf16_t*)p.GQKV + (size_t)n * 3 * GW + which * GW + lane * 4) = (u32x2){att::pk(vq[which][0], vq[which][1]), att::pk(vq[which][2], vq[which][3])};
        if (lane < 2 * GH) { p.GG[(size_t)n * 2 * GH + lane] = gg; p.GB[(size_t)n * 2 * GH + lane] = gb; }
        *(u32x2*)(p.LXRb + (size_t)n * LW + lane * 4) = (u32x2){att::pk(lacc[0], lacc[1]), att::pk(lacc[2], lacc[3])};
        *(u32x4*)(p.AQb + (size_t)n * AW + lane * 8) = wqk[0];
        if (lane < 16) *(u32x4*)(p.Kc + ((size_t)(b * AKH + (lane >> 3)) * KK + kk) * HD + (lane & 7) * 8) = wqk[1];
    }
    for (int it = blockIdx.x * 512 + tid; it < NB * AKH * (KK / 64) * HD * 4; it += gridDim.x * 512) {
        const int d = it % HD, qtr = (it / HD) % 4, rest = it / (HD * 4), kb = rest % (KK / 64), kvh = (rest / (KK / 64)) % AKH, b = rest / ((KK / 64) * AKH);
        const int n0 = (kb * 64 < SEQ ? b * SEQ + kb * 64 : NL + b * CTX + (kb * 64 - SEQ)) + qtr * 16;
        const bf16_t* vsrc = p.PROJb + (size_t)n0 * NPJ + O_A + AW + KVW + kvh * HD + d;
        bf16_t* vb = p.Vt + ((size_t)(b * AKH + kvh) * HD + d) * KK + kb * 64 + qtr * 16;
        unsigned w[8];
#pragma unroll
        for (int i = 0; i < 8; ++i) w[i] = (unsigned)vsrc[(size_t)(2 * i) * NPJ] | ((unsigned)vsrc[(size_t)(2 * i + 1) * NPJ] << 16);
        *(u32x4*)vb = (u32x4){w[0], w[1], w[2], w[3]}; *(u32x4*)(vb + 8) = (u32x4){w[4], w[5], w[6], w[7]};
    }
}
__device__ __forceinline__ void ph_readout_w(const P& p, int l, int ntok) {
    typedef float f32x4 __attribute__((ext_vector_type(4)));
    typedef unsigned u32x2 __attribute__((ext_vector_type(2)));
    int tid = threadIdx.x; HIDE(tid);
    const int lane = tid & 63, wave = blockIdx.x * 8 + (tid >> 6), nwaves = gridDim.x * 8, c0 = lane * 4;
    for (int n = wave; n < ntok; n += nwaves) {
        const bf16_t* pr = p.PROJb + (size_t)n * NPJ;
        {   const f32x4 v = *(const f32x4*)(p.GO + (size_t)n * GW + c0) + *(const f32x4*)(p.GO + ((size_t)NT + n) * GW + c0);
            float ss = v[0] * v[0] + v[1] * v[1] + v[2] * v[2] + v[3] * v[3];
            ss += __shfl_xor(ss, 1); ss += __shfl_xor(ss, 2); ss += __shfl_xor(ss, 4); ss += __shfl_xor(ss, 8);
            const float rs = frsq(ss * (1.0f / HD) + EPS);
            const f32x4 g = *(const f32x4*)(p.gdn_norm_g + l * HD + (c0 & (HD - 1))), gate = ldb4(pr + 3 * GW + c0);
            *(u32x2*)(p.MIXb + (size_t)n * D + c0) = (u32x2){att::pk(v[0] * rs * g[0] * siluf(gate[0]), v[1] * rs * g[1] * siluf(gate[1])), att::pk(v[2] * rs * g[2] * siluf(gate[2]), v[3] * rs * g[3] * siluf(gate[3]))};
        }
        {   const int bb = n < NL ? n / SEQ : (n - NL) / CTX;
            f32x4 hs = (f32x4){0.f, 0.f, 0.f, 0.f};
#pragma unroll
            for (int d = 0; d < 2; ++d) { const size_t ix = ((size_t)d * NT + n) * LW + c0;
                hs = hs + ldb4((const bf16_t*)p.LH + ix) + ldb4((const bf16_t*)p.LH + (size_t)2 * NT * LW + ix) * *(const f32x4*)(p.CARRY + ((size_t)(bb * 2 + d) * NCH + tok_chunk(n, d)) * LW + c0); }
            const f32x4 y = ldb4(pr + O_L + LW + c0);
            *(u32x2*)(p.MIXb + (size_t)n * D + GW + c0) = (u32x2){att::pk(hs[0] * gelu_tanhf(y[0]), hs[1] * gelu_tanhf(y[1])), att::pk(hs[2] * gelu_tanhf(y[2]), hs[3] * gelu_tanhf(y[3]))};
        }
    }
}
#endif


#ifdef HOST_EMU
#define WQ(minblk, nb)
#define HOSTB true
#define GTID0 ((int)gtid0)
#define LOADP
typedef int LdsPtr;
#define DO_WPREP
#define DO_INIT ph_init(p, gtid, gsize)
#define DO_INPROJ ph_inproj(p, l, gtid, gsize)
#define DO_OUTPROJ ph_outproj(p, l, ntok, gtid, gsize)
#define DO_MOE1 ph_moe1(p, l, gtid, gsize)
#define DO_MOE2 ph_moe2(p, l, gtid, gsize)
#define DO_ATTN ph_attn(p, l, ntok, gtid, gsize)
#define DO_GDN_A
#define DO_GDN_B ph_gdn_naive(p, l, gtid, gsize)
#define DO_MOD ph_mod(p, gtid, gsize)
#define DO_COMBINE_OR_MODRED if (l > 0) ph_combine(p, l - 1, ntok_prev, gtid, gsize)
#define DO_NORM1 ph_norm1(p, l, gtid, gsize)
#define DO_PREP ph_prep(p, l, gtid, gsize)
#define DO_LRU_CARRY ph_lru_carry(p, gtid, gsize)
#define DO_READOUT ph_readout(p, l, ntok, gtid, gsize)
#define DO_LRU_GATES
#define DO_LRU_LOCAL ph_lru_local(p, l, gtid, gsize)
#define DO_ROUTE ph_route(p, l, ntok, gtid, gsize)
#define DO_ROUTE2
#define DO_ROUTE3
#define DO_OFFSETS ph_offsets(p, gtid, gsize)
#define DO_SLOTS ph_slots(p, ntok, gtid, gsize)
#define DO_FINAL_COMBINE ph_combine(p, DEPTH - 1, NL, gtid, gsize)
#define DO_FINAL ph_final(p, gtid, gsize)
#else
#define HOSTB false
#define GTID0 ((int)(blockIdx.x * 512 + threadIdx.x))
typedef LAS unsigned char* LdsPtr;
typedef const __attribute__((address_space(4))) P* KernArgP;
#define LOADP P p_; { KernArgP k_ = (KernArgP)__builtin_amdgcn_kernarg_segment_ptr(); asm volatile("" : "+s"(k_)); const __attribute__((address_space(4))) unsigned long long* q_ = (const __attribute__((address_space(4))) unsigned long long*)k_; void** d_ = (void**)&p_; _Pragma("unroll") for (int i_ = 0; i_ < (int)(sizeof(P) / 8); ++i_) d_[i_] = (void*)(__attribute__((address_space(1))) void*)q_[i_]; }     const P& p = p_;
#ifndef MFMA_DENSE
#define MFMA_DENSE 1
#endif
#ifndef MFMA_MOE
#define MFMA_MOE 1
#endif
#define DO_INIT
#define DO_WPREP ph_wprep(p, lds); ph_wr_prep(p); ph_wl_prep(p); wq_pull(p, 0, -1, lds)
#define WQ(minblk, nb) do { if ((int)blockIdx.x >= (minblk)) wq_pull(p, l + 1, (nb), lds); } while (0)
#define DO_MOD ph_mod_part(p, lds)
#define DO_COMBINE_OR_MODRED if (l == 0) ph_mod_reduce(p)
#define DO_NORM1 ph_norm1_aux(p, gtid, gsize); ph_rownorm(p, l, l - 1, NT, NT)
#define DO_PREP ph_prep_w(p, l)
#define DO_LRU_CARRY ph_lru_carry_w(p, gtid - 128 * 512 < 0 ? gsize : gtid - 128 * 512, gsize)
#define DO_READOUT ph_readout_w(p, l, ntok)
#define DO_LRU_GATES ph_lru_gates(p, l, lds)
#define DO_LRU_LOCAL ph_lru_scan(p, l)
#define DO_ROUTE ph_norm2_w(p, l, ntok)
#define DO_ROUTE2 ph_rgemm(p, l, ntok, lds)
#define DO_ROUTE3 ph_topk(p, l, ntok, lds)
#define DO_OFFSETS
#define DO_SLOTS ph_slots_off_w(p, ntok)
#define DO_FINAL_COMBINE
#define DO_FINAL ph_rownorm(p, DEPTH, DEPTH - 1, NL, NL)
#ifndef MFMA_GDN
#define MFMA_GDN 1
#endif
#if MFMA_GDN
#define DO_GDN_A ph_gdn_a(p, l, lds)
#define DO_GDN_B ph_gdn_b(p, l, lds)
#else
#define DO_GDN_A
#define DO_GDN_B ph_gdn_naive(p, l, gtid, gsize)
#endif
#ifndef MFMA_ATTN
#define MFMA_ATTN 1
#endif
#if MFMA_ATTN
#define DO_ATTN ph_attn_mfma(p, l, ntok == NT, lds)
#else
#define DO_ATTN ph_attn(p, l, ntok, gtid, gsize)
#endif
#if MFMA_DENSE
#define DO_INPROJ ph_inproj_mfma(p, l, lds)
#define DO_OUTPROJ ph_outproj_mfma(p, l, ntok, lds)
#else
#define DO_INPROJ ph_inproj(p, l, gtid, gsize)
#define DO_OUTPROJ ph_outproj(p, l, ntok, gtid, gsize)
#endif
#if MFMA_MOE
#define DO_MOE1 ph_moe1_mfma(p, l, lds)
#define DO_MOE2 ph_moe2_mfma(p, l, lds)
#else
#define DO_MOE1 ph_moe1(p, l, gtid, gsize)
#define DO_MOE2 ph_moe2(p, l, gtid, gsize)
#endif
#endif
template <bool ALL, class BarFn>
DEV void run_phases(const P& p, int ph_lo, int ph_hi, long gtid0, long gsize, LdsPtr lds, BarFn bar) {
    int ph = 0;
#define PHASE(body) do { if (ALL || (ph >= ph_lo && ph < ph_hi)) { int gt_ = GTID0; HIDE(gt_); const long gtid = gt_; { LOADP; body; } if (ALL || ph + 1 < ph_hi) bar(); } if (!ALL) ++ph; } while (0)
#define PHASE_IF(cond, body) do { if (cond) PHASE(body); } while (0)
    PHASE({ DO_MOD; DO_INIT; ph_rope(p, gtid, gsize); DO_WPREP; });
#define LAYER(L_) if (L_ < DEPTH) { constexpr int l = L_; \
        const int ntok = l < DEPTH - 1 ? NT : NL;         \
        const int ntok_prev = l - 1 < DEPTH - 1 ? NT : NL; \
        PHASE_IF(HOSTB || l == 0, { DO_COMBINE_OR_MODRED; }); \
        PHASE({ DO_NORM1; }); \
        PHASE({ DO_INPROJ; }); \
        PHASE({ DO_PREP; }); \
        PHASE_IF(!HOSTB, { DO_LRU_GATES; }); \
        PHASE({ DO_GDN_A; DO_LRU_LOCAL; }); \
        PHASE({ DO_GDN_B; DO_LRU_CARRY; DO_ATTN; }); \
        PHASE({ DO_READOUT; }); \
        PHASE({ DO_OUTPROJ; WQ(32, 5); }); \
        PHASE({ DO_ROUTE; }); \
        PHASE_IF(!HOSTB, { DO_ROUTE2; WQ(216, 3); }); \
        PHASE_IF(!HOSTB, { DO_ROUTE3; WQ(0, 3); }); \
        PHASE_IF(HOSTB, { DO_OFFSETS; }); \
        PHASE({ DO_SLOTS; WQ(8, -1); }); \
        PHASE({ DO_MOE1; }); \
        PHASE({ DO_MOE2; }); \
    }
    LAYER(0) LAYER(1) LAYER(2) LAYER(3)
#undef LAYER
    static_assert(DEPTH <= 4, "LAYER instances");
    PHASE_IF(HOSTB, { DO_FINAL_COMBINE; });
    { int gt_ = GTID0; HIDE(gt_); const long gtid = gt_; if (ALL || (ph >= ph_lo && ph < ph_hi)) { LOADP; DO_FINAL; } }
#undef PHASE
}
constexpr int TOTAL_PHASES = 1 + 13 * DEPTH + 2;

struct Carver { char* base; size_t off; template <class T> T* take(size_t n) { off = (off + 255) & ~(size_t)255; T* r = (T*)(base + off); off += n * sizeof(T); return r; } };
static inline size_t carve(P& p, void* ws) {
    Carver c{(char*)ws, 0};
    p.bar = c.take<unsigned>(4096);
    p.CNT = c.take<int>(NE); p.OFF = c.take<int>((NE + 1) * 32); p.BLKE = c.take<int>(NBLK * 32);
    p.X = c.take<float>((size_t)NT * D); p.ROPE = c.take<float>((size_t)SEQ * 64); p.PART = c.take<float>((size_t)8 * DEPTH * (NB + 1) * 6 * D); p.CARRY = c.take<float>((size_t)NB * 2 * NCH * LW); p.MOD = c.take<float>((size_t)DEPTH * (NB + 1) * 6 * D); p.HNb = c.take<bf16_t>((size_t)NT * D);
#ifdef HOST_EMU
    p.PROJ = c.take<float>((size_t)NT * PJS); p.AQ = c.take<float>((size_t)NT * AW); p.AK = c.take<float>((size_t)NT * KVW); p.Y = c.take<float>((size_t)NSLOT * D);
#endif
    p.GQKV = c.take<float>((size_t)NT * 3 * GW); p.GG = c.take<float>((size_t)NT * 2 * GH); p.GB = c.take<float>((size_t)NT * 2 * GH);
    p.GO = c.take<float>((size_t)2 * NT * GW); p.LXR = c.take<float>((size_t)NT * LW); p.LA = c.take<float>((size_t)2 * NT * LW);
    p.LH = c.take<float>((size_t)2 * NT * LW); p.MIXb = c.take<bf16_t>((size_t)NT * D);
    p.H2b = c.take<bf16_t>((size_t)NT * H2S); p.LOGIT = c.take<float>((size_t)3 * NT * 128); p.RG = c.take<float>((size_t)NT * 2); p.RE = c.take<int>((size_t)NT * 2);
    p.SLOT_TOK = c.take<int>(NSLOT); p.SLOT_OF = c.take<int>((size_t)NT * 2 * 32); p.ACTb = c.take<bf16_t>((size_t)NSLOT * HID);
    p.LXRb = c.take<bf16_t>((size_t)NT * LW); p.LBX = c.take<float>((size_t)2 * NT * LW);
    p.AQb = c.take<bf16_t>((size_t)NT * AW); p.Kc = c.take<bf16_t>((size_t)NB * AKH * KK * HD); p.Vt = c.take<bf16_t>((size_t)NB * AKH * HD * KK);
#ifndef HOST_EMU
    p.Yb = c.take<bf16_t>((size_t)NSLOT * D);
    p.PROJb = c.take<bf16_t>((size_t)NT * NPJ); p.AB = c.take<float>((size_t)NT * 32);
    { const size_t ncp = (size_t)NB * GH * 2 * ((CTX + SEQ) / 64); p.GWN = c.take<bf16_t>(ncp * 4096); p.GQG = c.take<bf16_t>(ncp * 4096); p.GQK = c.take<bf16_t>(ncp * 4096); p.GKT = c.take<bf16_t>(ncp * 4096); p.GU = c.take<float>(ncp * 4096); p.GEL = c.take<float>(ncp * 32); }
    p.WinT = c.take<bf16_t>((size_t)DEPTH * NPJ * D); p.WoutT = c.take<bf16_t>((size_t)DEPTH * D * D);
    p.WrT = c.take<bf16_t>((size_t)DEPTH * 256 * H2S); p.WlT = c.take<bf16_t>((size_t)DEPTH * 4 * LW * LW); p.W13T = c.take<bf16_t>((size_t)DEPTH * NE * 2 * HID * D); p.W2T = c.take<bf16_t>((size_t)DEPTH * NE * D * HID);
#endif
    return c.off;
}
static inline void set_inputs(P& p, void* const* d_in, void* d_out) {
    const float** f = (const float**)&p.x;
    for (int i = 0; i < 31; ++i) f[i] = (const float*)d_in[i];
    p.out = (float*)d_out;
}

#ifndef HOST_EMU
#define XB_TMO      128
#define XB_XCNT(j)  (256  + 64 * (j))
#define XB_XSUB(j)  (1280 + 64 * (j))
#define XB_XGEN(j)  (2304 + 64 * (j))
#define XB_TOP      3328
#define XB_TOPGEN   3392
#define XCD_BAR_WORDS 3456
#define XB_SPIN_CAP (1u << 18)
__device__ __forceinline__ unsigned xb_ld(unsigned* p)              { return __hip_atomic_load(p, __ATOMIC_RELAXED, __HIP_MEMORY_SCOPE_AGENT); }
__device__ __forceinline__ unsigned xb_add(unsigned* p, unsigned v) { return __hip_atomic_fetch_add(p, v, __ATOMIC_RELAXED, __HIP_MEMORY_SCOPE_AGENT); }
__device__ __forceinline__ unsigned xb_xcc_id() { return (unsigned)__builtin_amdgcn_s_getreg((3 << 11) | 20) & 0xFu; }
#define XB_SPIN(cond, bar) do { unsigned _sp = 0; while (cond) { __builtin_amdgcn_s_sleep(1); \
    if ((++_sp & 255u) == 0u) { if (xb_ld(&(bar)[XB_TMO])) break; if (_sp > XB_SPIN_CAP) { atomicAdd(&(bar)[XB_TMO], 1u); break; } } } } while (0)
struct XcdBarrier { unsigned* bar; unsigned x; volatile LAS unsigned* st; };
__device__ __forceinline__ XcdBarrier xcd_barrier_post(unsigned* bar, volatile LAS unsigned* st) {
    XcdBarrier b; b.bar = bar; b.x = xb_xcc_id(); b.st = st;
    if (threadIdx.x == 0) (void)xb_add(&bar[XB_XCNT(b.x)], 1u);
    return b;
}
__device__ __forceinline__ void xcd_barrier_complete(unsigned* bar, unsigned x, unsigned& nloc, unsigned& nx) {
    const unsigned G = gridDim.x * gridDim.y * gridDim.z;
    unsigned sum, cnt, mine, sp = 0u;
    for (;;) {
        sum = 0u; cnt = 0u; mine = 0u;
#pragma unroll
        for (unsigned j = 0; j < 16; ++j) { const unsigned c = xb_ld(&bar[XB_XCNT(j)]); sum += c; cnt += (c > 0u) ? 1u : 0u; mine = (j == x) ? c : mine; }
        if (sum == G) break;
        __builtin_amdgcn_s_sleep(1);
        if ((++sp & 255u) == 0u) { if (xb_ld(&bar[XB_TMO])) break; if (sp > XB_SPIN_CAP) { atomicAdd(&bar[XB_TMO], 1u); break; } }
    }
    nloc = mine > 0u ? mine : 1u; nx = cnt > 0u ? cnt : 1u;
}
__device__ __forceinline__ void xcd_barrier(const XcdBarrier& b) {
    asm volatile("s_waitcnt vmcnt(0)" ::: "memory");
    __syncthreads();
    if (threadIdx.x == 0) {
        unsigned long long bq_ = (unsigned long long)b.bar; asm volatile("" : "+s"(bq_)); unsigned* bar = (unsigned*)(__attribute__((address_space(1))) unsigned*)bq_;
        __builtin_amdgcn_s_waitcnt(0);
        unsigned nloc = b.st[0], nx = b.st[1];
        if (nloc == 0u) { xcd_barrier_complete(bar, b.x, nloc, nx); b.st[0] = nloc; b.st[1] = nx; }
        const unsigned old = xb_add(&bar[XB_XSUB(b.x)], 1u);
        const unsigned gen = old / nloc;
        if (old + 1u == (gen + 1u) * nloc) {
            __builtin_amdgcn_fence(__ATOMIC_RELEASE, "agent");
            asm volatile("s_waitcnt vmcnt(0)" ::: "memory");
            const unsigned og = xb_add(&bar[XB_TOP], 1u);
            const unsigned tg = og / nx;
            if (og + 1u == (tg + 1u) * nx) xb_add(&bar[XB_TOPGEN], 1u);
            else XB_SPIN(xb_ld(&bar[XB_TOPGEN]) == tg, bar);
            __builtin_amdgcn_fence(__ATOMIC_ACQUIRE, "agent");
            xb_add(&bar[XB_XGEN(b.x)], 1u);
            asm volatile("s_waitcnt vmcnt(0)" ::: "memory");
        } else {
            XB_SPIN(xb_ld(&bar[XB_XGEN(b.x)]) == gen, bar);
            __builtin_amdgcn_fence(__ATOMIC_ACQUIRE, "agent");
            asm volatile("s_waitcnt vmcnt(0)" ::: "memory");
        }
    }
    __syncthreads();
}

constexpr int NTHREADS = 512;
constexpr int LDS_BYTES = 147456, LDS_MISC = 131072;
__global__ void __launch_bounds__(NTHREADS, 2) mega(P p, int ph_lo, int ph_hi) {
    extern __shared__ __attribute__((aligned(16))) unsigned char lds_raw[];
    LAS unsigned char* lds = (LAS unsigned char*)lds_raw;
    volatile LAS unsigned* misc = (volatile LAS unsigned*)(lds + LDS_MISC);
    if (threadIdx.x < 4) misc[threadIdx.x] = 0u;
    __syncthreads();
    if (threadIdx.x == 0) misc[2] = xb_xcc_id();
    (void)xcd_barrier_post(p.bar, misc);
    __syncthreads();
    const long gtid = 0, gsize = (long)gridDim.x * NTHREADS;
    auto bar = []() { LOADP; LAS unsigned char* l_ = (LAS unsigned char*)0; volatile LAS unsigned* m_ = (volatile LAS unsigned*)(l_ + LDS_MISC); XcdBarrier b; b.bar = p.bar; b.x = m_[2]; b.st = m_; xcd_barrier(b); };
#ifdef MK_MULTI
    run_phases<false>(p, ph_lo, ph_hi, gtid, gsize, lds, bar);
#else
    run_phases<true>(p, ph_lo, ph_hi, gtid, gsize, lds, bar);
#endif
}

extern "C" void kernel_launch(void* const* d_in, const int* in_sizes, int n_in, void* d_out, int out_size, void* d_ws, size_t ws_size, hipStream_t stream) {
    P p{}; set_inputs(p, d_in, d_out);
    if (carve(p, d_ws) > ws_size) { fprintf(stderr, "kernel_launch: workspace too small\n"); return; }
    static int grid = 0;
    if (!grid) {
        int dev = 0, cus = 0;
        (void)hipGetDevice(&dev); (void)hipDeviceGetAttribute(&cus, hipDeviceAttributeMultiprocessorCount, dev);
        (void)hipFuncSetAttribute((const void*)mega, hipFuncAttributeMaxDynamicSharedMemorySize, LDS_BYTES);
        grid = cus > 0 ? cus : 256;
    }
    (void)hipMemsetAsync(p.bar, 0, 4096 * sizeof(unsigned), stream);
#ifdef MK_MULTI
    for (int ph = 0; ph < TOTAL_PHASES; ++ph) mega<<<grid, NTHREADS, LDS_BYTES, stream>>>(p, ph, ph + 1);
#else
    mega<<<grid, NTHREADS, LDS_BYTES, stream>>>(p, 0, TOTAL_PHASES);
#endif
}
#endif
```

```cpp
#ifndef HOST_EMU
#include <hip/hip_runtime.h>
#endif
#include <cstdio>
#include <cstdint>
#include <cmath>


#ifndef CFG_D
#define CFG_D 1024
#define CFG_B 8
#define CFG_SEQ 2048
#define CFG_DEPTH 4
#define CFG_CTX 256
#define CFG_HID 512
#endif

#ifdef HOST_EMU
#define HIDE(x)
#define VZ 0
#define STORE_WT(ptr, v) (*(ptr) = (v))
#define DEV static inline
#define HD_INLINE static inline
static inline int atomicAdd(int* p, int v) { int o = *p; *p = o + v; return o; }
#else
#define HIDE(x) asm volatile("" : "+v"(x))
#define VZ ({ int z_ = 0; asm volatile("" : "+v"(z_)); z_; })
#define STORE_WT(ptr, v) __hip_atomic_store((ptr), (v), __ATOMIC_RELAXED, __HIP_MEMORY_SCOPE_AGENT)
#define DEV __device__ __forceinline__
#endif

constexpr int D = CFG_D, NB = CFG_B, SEQ = CFG_SEQ, DEPTH = CFG_DEPTH, CTX = CFG_CTX, HID = CFG_HID;
constexpr int HD = 64, GW = D / 4, GH = GW / HD, LW = D / 4, LBW = LW / 4, AW = D - GW - LW, AQH = AW / HD, AKH = 2, AG = AQH / AKH, KVW = AKH * HD;
constexpr int GP = 4 * GW + 4 * GH, LP = 2 * LW, AP = AW + 2 * KVW, PJ = GP + LP + AP;
constexpr int O_L = GP, O_A = GP + LP;
constexpr int NL = NB * SEQ, NC = NB * CTX, NT = NL + NC;
constexpr int NE = 64, NG = 8, EPG = 8, NLOG = NG + NE;
constexpr int MBLK = 256, NPJ = ((PJ + 255) / 256) * 256, PJS = NPJ  , NSLOT = NT * 2 + NE * MBLK, NBLK = NSLOT / MBLK;
constexpr int H2S = 3 * D;
constexpr int KK = SEQ + CTX;
constexpr float EPS = 1e-6f, QSCALE = 0.125f * 1.4426950408889634f;
static_assert(NSLOT % MBLK == 0, "slots");

typedef unsigned short bf16_t;
struct P {
    const float *x, *c, *ctx, *c_ctx, *w_ada, *b_ada, *norm1_g, *norm2_g, *w_in, *w_out, *gdn_conv_w, *gdn_a_log, *gdn_dt_bias, *gdn_norm_g;
    const float *lru_conv_w, *lru_conv_b, *lru_w_r, *lru_b_r, *lru_w_i, *lru_b_i, *lru_lambda, *attn_q_norm_g, *attn_k_norm_g;
    const float *moe_w_group, *moe_b_group, *moe_w_expert, *moe_b_expert, *moe_w1, *moe_w3, *moe_w2, *final_norm_g;
    float* out;
    unsigned* bar;
    float *AB, *LOGIT, *X, *MOD, *PART, *ROPE, *CARRY, *PROJ, *GQKV, *GG, *GB, *GO, *LXR, *LA, *LBX, *LH, *AQ, *AK, *RG, *Y;
    int *RE, *CNT, *OFF, *BLKE, *SLOT_TOK, *SLOT_OF;
    bf16_t *Yb, *HNb, *MIXb, *H2b, *ACTb, *WinT, *WoutT, *W13T, *W2T, *WrT, *WlT, *LXRb, *PROJb, *AQb, *Kc, *Vt, *GWN, *GQG, *GQK, *GKT;
    float *GU, *GEL;
};

#ifdef HOST_EMU
DEV float fexp(float x) { return expf(x); }
DEV float flog(float x) { return logf(x); }
DEV float frcp(float x) { return 1.0f / x; }
DEV float frsq(float x) { return 1.0f / sqrtf(x); }
#else
DEV float fexp(float x) { return __expf(x); }
DEV float flog(float x) { return __logf(x); }
DEV float frcp(float x) { return __builtin_amdgcn_rcpf(x); }
DEV float frsq(float x) { return __builtin_amdgcn_rsqf(x); }
#endif
DEV float siluf(float x) { return x * frcp(1.f + fexp(-x)); }
DEV float sigmoidf(float x) { return frcp(1.f + fexp(-x)); }
DEV float softplusf(float x) { if (x > 15.f) return x; const float e = fexp(x); return e < 1e-3f ? e * (1.f - 0.5f * e) : flog(1.f + e); }
DEV float neg_expm1f(float y) { return fabsf(y) < 0.01f ? -y * (1.f + y * (0.5f + y * 0.16666667f)) : 1.f - fexp(y); }
DEV float gelu_tanhf(float x) { const float u = 0.7978845608028654f * (x + 0.044715f * x * x * x); return x * frcp(1.f + fexp(-2.f * u)); }
DEV bf16_t f2bf(float f) { unsigned u = __builtin_bit_cast(unsigned, f); return (bf16_t)((u + 0x7fffu + ((u >> 16) & 1u)) >> 16); }
DEV float bf2f(bf16_t h) { return __builtin_bit_cast(float, (unsigned)h << 16); }
DEV int tok_modrow(int n) { return n < NL ? n / SEQ : NB; }
DEV void tok_seg(int n, int& s0, int& len) { if (n < NL) { s0 = (n / SEQ) * SEQ; len = SEQ; } else { s0 = NL + ((n - NL) / CTX) * CTX; len = CTX; } }

DEV void ph_mod(const P& p, long gtid, long gsize) {
    for (long it = gtid; it < (long)DEPTH * 6 * D; it += gsize) {
        const int l = (int)(it / (6 * D)), j = (int)(it % (6 * D));
        float acc[NB + 1];
#pragma unroll
        for (int r = 0; r <= NB; ++r) acc[r] = 0.f;
        const float* w = p.w_ada + (size_t)l * D * 6 * D + j;
        for (int k = 0; k < D; ++k) {
            const float wv = w[(size_t)k * 6 * D];
#pragma unroll
            for (int r = 0; r <= NB; ++r) { const float cv = r < NB ? p.c[r * D + k] : p.c_ctx[k]; acc[r] += siluf(cv) * wv; }
        }
        const float bv = p.b_ada[l * 6 * D + j];
#pragma unroll
        for (int r = 0; r <= NB; ++r) p.MOD[((size_t)l * (NB + 1) + r) * 6 * D + j] = acc[r] + bv;
    }
}
DEV void ph_rope(const P& p, long gtid, long gsize) {
    for (long it = gtid; it < (long)SEQ * 16; it += gsize) {
        const int t = (int)(it / 16), i = (int)(it % 16);
        const float inv = powf(10000.0f, -(float)(2 * i) / 32.0f), ar = (float)(t / 64) * inv, ac = (float)(t % 64) * inv;
        float* rt = p.ROPE + (size_t)t * 64;
        rt[i] = cosf(ar); rt[16 + i] = sinf(ar); rt[32 + i] = cosf(ac); rt[48 + i] = sinf(ac);
    }
}
DEV void ph_init(const P& p, long gtid, long gsize) {
    for (long it = gtid; it < (long)NT * D; it += gsize) p.X[it] = it < (long)NL * D ? p.x[it] : p.ctx[it - (long)NL * D];
}
DEV void norm_row(const P& p, int l, int n, int which, bf16_t* dst) {
    const float* xr = p.X + (size_t)n * D;
    float ss = 0.f;
    for (int k = 0; k < D; ++k) ss += xr[k] * xr[k];
    const float rs = frsq(ss / D + EPS);
    const float* g = (which ? p.norm2_g : p.norm1_g) + l * D;
    const float* md = p.MOD + ((size_t)l * (NB + 1) + tok_modrow(n)) * 6 * D + (which ? 3 * D : 0);
    for (int k = 0; k < D; ++k) dst[k] = f2bf(xr[k] * rs * g[k] * (1.f + md[D + k]) + md[k]);
}
DEV void ph_norm1_aux(const P& p, long gtid, long gsize);
DEV void ph_norm1(const P& p, int l, long gtid, long gsize) {
    for (long it = gtid; it < NT; it += gsize) norm_row(p, l, (int)it, 0, p.HNb + (size_t)it * D);
    ph_norm1_aux(p, gtid, gsize);
}
DEV void ph_norm1_aux(const P& p, long gtid, long gsize) {
    for (long it = gtid; it < NE; it += gsize) p.CNT[it] = 0;
}

template <bool DUAL, class RowA, class Epi>
DEV void gemm_naive(int Mtiles, int N, int K, RowA rowA, const float* B, const float* B2, int ldb, Epi epi, long gtid, long gsize) {
    const int nt = N / 4;
    for (long it = gtid; it < (long)Mtiles * nt; it += gsize) {
        const int mt = (int)(it / nt), n0 = (int)(it % nt) * 4;
        const bf16_t* a[4]; const float* Bb = B; const float* Bb2 = B2; bool any = false;
#pragma unroll
        for (int i = 0; i < 4; ++i) { a[i] = rowA(mt * 4 + i, Bb, Bb2); any |= a[i] != nullptr; }
        if (!any) continue;
        float acc[4][4], acc2[4][4];
#pragma unroll
        for (int i = 0; i < 4; ++i)
#pragma unroll
            for (int j = 0; j < 4; ++j) { acc[i][j] = 0.f; acc2[i][j] = 0.f; }
        for (int k = 0; k < K; ++k) {
            const float* bp = Bb + (size_t)k * ldb + n0;
            const float b0 = bp[0], b1 = bp[1], b2 = bp[2], b3 = bp[3];
            float c0 = 0, c1 = 0, c2 = 0, c3 = 0;
            if (DUAL) { const float* bq = Bb2 + (size_t)k * ldb + n0; c0 = bq[0]; c1 = bq[1]; c2 = bq[2]; c3 = bq[3]; }
#pragma unroll
            for (int i = 0; i < 4; ++i) {
                const float av = a[i] ? bf2f(a[i][k]) : 0.f;
                acc[i][0] += av * b0; acc[i][1] += av * b1; acc[i][2] += av * b2; acc[i][3] += av * b3;
                if (DUAL) { acc2[i][0] += av * c0; acc2[i][1] += av * c1; acc2[i][2] += av * c2; acc2[i][3] += av * c3; }
            }
        }
#pragma unroll
        for (int i = 0; i < 4; ++i) if (a[i]) epi(mt * 4 + i, n0, acc[i], acc2[i]);
    }
}

DEV void ph_inproj(const P& p, int l, long gtid, long gsize) {
    const float* W = p.w_in + (size_t)l * D * PJ;
    gemm_naive<false>(NT / 4, PJ, D,
        [&](int m, const float*&, const float*&) { return p.HNb + (size_t)m * D; }, W, nullptr, PJ,
        [&](int m, int n0, const float* acc, const float*) { float* o = p.PROJ + (size_t)m * PJS + n0; o[0] = acc[0]; o[1] = acc[1]; o[2] = acc[2]; o[3] = acc[3]; },
        gtid, gsize);
}

DEV float conv4(const P& p, int n, int s0, int len, const float* w, int wstride, int c, int col) {
    float acc = 0.f;
#pragma unroll
    for (int j = 0; j < 4; ++j) { const int m = n + j - 1; if (m >= s0 && m < s0 + len) acc += w[j * wstride + c] * p.PROJ[(size_t)m * PJS + col]; }
    return acc;
}
DEV void ph_prep(const P& p, int l, long gtid, long gsize) {
    for (long it = gtid; it < (long)NT * 3 * GH; it += gsize) {
        const int n = (int)(it / (3 * GH)), wh = (int)(it % (3 * GH)), which = wh / GH, h = wh % GH;
        int s0, len; tok_seg(n, s0, len);
        const float* w = p.gdn_conv_w + (size_t)l * 4 * 3 * GW;
        float* o = p.GQKV + (size_t)n * 3 * GW + which * GW + h * HD;
        float ss = 0.f;
        for (int d = 0; d < HD; ++d) { const int c = which * GW + h * HD + d; const float v = siluf(conv4(p, n, s0, len, w, 3 * GW, c, c)); ss += v * v; o[d] = v; }
        if (which < 2) {
            float sc = frsq(ss + EPS); if (which == 0) sc *= 0.125f;
            for (int d = 0; d < HD; ++d) o[d] *= sc;
        }
    }
    for (long it = gtid; it < (long)NT * 2 * GH; it += gsize) {
        const int n = (int)(it / (2 * GH)), dh = (int)(it % (2 * GH));
        const float al = p.PROJ[(size_t)n * PJS + 4 * GW + dh], be = p.PROJ[(size_t)n * PJS + 4 * GW + 2 * GH + dh];
        p.GG[it] = -fexp(p.gdn_a_log[l * 2 * GH + dh]) * softplusf(al + p.gdn_dt_bias[l * 2 * GH + dh]);
        p.GB[it] = sigmoidf(be);
    }
    for (long it = gtid; it < (long)NT * LW; it += gsize) {
        const int n = (int)(it / LW), c = (int)(it % LW);
        int s0, len; tok_seg(n, s0, len);
        const float xv = conv4(p, n, s0, len, p.lru_conv_w + (size_t)l * 4 * LW, LW, c, O_L + c) + p.lru_conv_b[l * LW + c];
        p.LXR[it] = xv; p.LXRb[it] = f2bf(xv);
    }
    for (long it = gtid; it < (long)NT * (AQH + AKH); it += gsize) {
        const int n = (int)(it / (AQH + AKH)), hh = (int)(it % (AQH + AKH));
        const bool isq = hh < AQH;
        const float* src = p.PROJ + (size_t)n * PJS + O_A + (isq ? hh * HD : AW + (hh - AQH) * HD);
        const float* g = (isq ? p.attn_q_norm_g : p.attn_k_norm_g) + l * HD;
        float ss = 0.f;
        for (int d = 0; d < HD; ++d) ss += src[d] * src[d];
        const float rs = frsq(ss / HD + EPS);
        float* o = isq ? p.AQ + (size_t)n * AW + hh * HD : p.AK + (size_t)n * KVW + (hh - AQH) * HD;
        if (n < NL) {
            const int t = n % SEQ;
            const float* rt = p.ROPE + (size_t)t * 64;
            for (int i = 0; i < 16; ++i) {
                const float cr = rt[i], sr = rt[16 + i], cc = rt[32 + i], sc = rt[48 + i];
                const float x1 = src[i] * rs * g[i], x2 = src[16 + i] * rs * g[16 + i], y1 = src[32 + i] * rs * g[32 + i], y2 = src[48 + i] * rs * g[48 + i];
                o[i] = x1 * cr - x2 * sr; o[16 + i] = x1 * sr + x2 * cr;
                o[32 + i] = y1 * cc - y2 * sc; o[48 + i] = y1 * sc + y2 * cc;
            }
        } else {
            for (int d = 0; d < HD; ++d) o[d] = src[d] * rs * g[d];
        }
        const int b = n < NL ? n / SEQ : (n - NL) / CTX, kk = n < NL ? n % SEQ : SEQ + (n - NL) % CTX;
        if (isq) { bf16_t* qb = p.AQb + (size_t)n * AW + hh * HD; for (int d = 0; d < HD; ++d) qb[d] = f2bf(o[d] * QSCALE); }
        else {
            const int kvh = hh - AQH;
            bf16_t* kb = p.Kc + ((size_t)(b * AKH + kvh) * KK + kk) * HD; for (int d = 0; d < HD; ++d) kb[d] = f2bf(o[d]);
        }
    }
    for (long it = gtid; it < (long)NB * AKH * (KK / 64) * HD; it += gsize) {
        const int d = (int)(it % HD), kb = (int)(it / HD) % (KK / 64), kvh = (int)(it / (HD * (KK / 64))) % AKH, b = (int)(it / (HD * (KK / 64) * AKH));
        const int n0 = kb * 64 < SEQ ? b * SEQ + kb * 64 : NL + b * CTX + (kb * 64 - SEQ);
        const float* vsrc = p.PROJ + (size_t)n0 * PJS + O_A + AW + KVW + kvh * HD + d;
        bf16_t* vb = p.Vt + ((size_t)(b * AKH + kvh) * HD + d) * KK + kb * 64;
        for (int i = 0; i < 64; i += 2) { const unsigned w = (unsigned)f2bf(vsrc[(size_t)i * PJS]) | ((unsigned)f2bf(vsrc[(size_t)(i + 1) * PJS]) << 16); *(unsigned*)(vb + i) = w; }
    }
}
constexpr int NCH = (CTX + SEQ) / 64, NCC = CTX / 64;
DEV int chunk_tok(int b, int dir, int ci, int i) {
    if (ci < NCC) { const int pos = ci * 64 + i; return NL + b * CTX + (dir ? CTX - 1 - pos : pos); }
    const int pos = (ci - NCC) * 64 + i; return b * SEQ + (dir ? SEQ - 1 - pos : pos);
}
DEV int tok_chunk(int n, int dir) {
    if (n < NL) { const int t = n % SEQ; return NCC + (dir ? SEQ - 1 - t : t) / 64; }
    const int sidx = (n - NL) % CTX; return (dir ? CTX - 1 - sidx : sidx) / 64;
}
DEV void ph_lru_local(const P& p, int l, long gtid, long gsize) {
    for (long it = gtid; it < (long)NB * 2 * NCH * LW; it += gsize) {
        const int c = (int)(it % LW), ci = (int)(it / LW) % NCH, dir = (int)(it / (LW * NCH)) % 2, b = (int)(it / (LW * NCH * 2)), blk = c / LBW, e = c % LBW;
        const float* wr = p.lru_w_r + ((size_t)(l * 2 + dir) * 4 + blk) * LBW * LBW + e;
        const float* wi = p.lru_w_i + ((size_t)(l * 2 + dir) * 4 + blk) * LBW * LBW + e;
        const float br = p.lru_b_r[(l * 2 + dir) * LW + c], bi = p.lru_b_i[(l * 2 + dir) * LW + c], sp = softplusf(-p.lru_lambda[(l * 2 + dir) * LW + c]);
        float h = 0.f, A = 1.f;
        for (int i = 0; i < 64; ++i) {
            const int n = chunk_tok(b, dir, ci, i);
            const float* xr = p.LXR + (size_t)n * LW + blk * LBW;
            float ar = 0.f, ai = 0.f;
            for (int d = 0; d < LBW; ++d) { const float xv = xr[d]; ar += xv * wr[d * LBW]; ai += xv * wi[d * LBW]; }
            const float r = sigmoidf(ar + br), ig = sigmoidf(ai + bi), log_a = -8.0f * r * sp, a = fexp(log_a);
            const float bx = sqrtf(neg_expm1f(2.0f * log_a)) * (ig * p.LXR[(size_t)n * LW + c]);
            h = a * h + bx; A *= a;
            const size_t ix = ((size_t)dir * NT + n) * LW + c;
            p.LH[ix] = h; p.LA[ix] = A;
        }
    }
}
#ifndef HOST_EMU
__device__ __forceinline__ void ph_lru_carry_w(const P& p, long gtid, long gsize) {
    const bf16_t* LHb = (const bf16_t*)p.LH; const bf16_t* LAb = LHb + (size_t)2 * NT * LW;
    for (long it = gtid; it < (long)NB * 2 * LW; it += gsize) {
        const int c = (int)(it % LW), dir = (int)(it / LW) % 2, b = (int)(it / (2 * LW));
        float H = 0.f;
        for (int ci = 0; ci < NCH; ++ci) {
            p.CARRY[((size_t)(b * 2 + dir) * NCH + ci) * LW + c] = H;
            const size_t ix = ((size_t)dir * NT + chunk_tok(b, dir, ci, 63)) * LW + c;
            H = bf2f(LAb[ix]) * H + bf2f(LHb[ix]);
        }
    }
}
#endif
DEV void ph_lru_carry(const P& p, long gtid, long gsize) {
    for (long it = gtid; it < (long)NB * 2 * LW; it += gsize) {
        const int c = (int)(it % LW), dir = (int)(it / LW) % 2, b = (int)(it / (2 * LW));
        float H = 0.f;
        for (int ci = 0; ci < NCH; ++ci) {
            p.CARRY[((size_t)(b * 2 + dir) * NCH + ci) * LW + c] = H;
            const size_t ix = ((size_t)dir * NT + chunk_tok(b, dir, ci, 63)) * LW + c;
            H = p.LA[ix] * H + p.LH[ix];
        }
    }
}
DEV void ph_gdn_naive(const P& p, int l, long gtid, long gsize) {
    for (long it = gtid; it < (long)NB * GH * 2 * HD; it += gsize) {
        const int dv = (int)(it % HD), dir = (int)(it / HD) % 2, h = (int)(it / (2 * HD)) % GH, b = (int)(it / (2 * HD * GH));
        float S[HD];
#pragma unroll
        for (int d = 0; d < HD; ++d) S[d] = 0.f;
        for (int ph = 0; ph < 2; ++ph) {
            const int len = ph == 0 ? CTX : SEQ, base = ph == 0 ? NL + b * CTX : b * SEQ;
            for (int i = 0; i < len; ++i) {
                const int n = base + (dir == 0 ? i : len - 1 - i);
                const float a = fexp(p.GG[(size_t)n * 2 * GH + dir * GH + h]), bt = p.GB[(size_t)n * 2 * GH + dir * GH + h];
                const float* q = p.GQKV + (size_t)n * 3 * GW + h * HD; const float* k = q + GW; const float v = q[2 * GW + dv];
                float ks = 0.f;
#pragma unroll
                for (int d = 0; d < HD; ++d) { S[d] *= a; ks += k[d] * S[d]; }
                const float cc = bt * (v - ks); float o = 0.f;
#pragma unroll
                for (int d = 0; d < HD; ++d) { S[d] += k[d] * cc; o += q[d] * S[d]; }
                p.GO[((size_t)dir * NT + n) * GW + h * HD + dv] = o;
            }
        }
    }
}
DEV void ph_attn(const P& p, int l, int ntok, long gtid, long gsize) {
    for (long it = gtid; it < (long)ntok * AQH; it += gsize) {
        const int n = (int)(it / AQH), hq = (int)(it % AQH), kvh = hq / AG;
        const float* qp = p.AQ + (size_t)n * AW + hq * HD;
        float q[HD], o[HD];
#pragma unroll
        for (int d = 0; d < HD; ++d) { q[d] = qp[d] * 0.125f; o[d] = 0.f; }
        float m = -1e30f, lsum = 0.f;
        const int b = n < NL ? n / SEQ : (n - NL) / CTX;
        for (int ph = (n < NL ? 0 : 1); ph < 2; ++ph) {
            const int len = ph == 0 ? SEQ : CTX, base = ph == 0 ? b * SEQ : NL + b * CTX;
            for (int j = 0; j < len; ++j) {
                const float* kp = p.AK + (size_t)(base + j) * KVW + kvh * HD;
                const float* vp = p.PROJ + (size_t)(base + j) * PJS + O_A + AW + KVW + kvh * HD;
                float s = 0.f;
#pragma unroll
                for (int d = 0; d < HD; ++d) s += q[d] * kp[d];
                const float mn = fmaxf(m, s), corr = fexp(m - mn), pe = fexp(s - mn);
                lsum = lsum * corr + pe;
#pragma unroll
                for (int d = 0; d < HD; ++d) o[d] = o[d] * corr + pe * vp[d];
                m = mn;
            }
        }
        const float inv = 1.f / lsum; bf16_t* op = p.MIXb + (size_t)n * D + GW + LW + hq * HD;
#pragma unroll
        for (int d = 0; d < HD; ++d) op[d] = f2bf(o[d] * inv);
    }
}
DEV void ph_readout(const P& p, int l, int ntok, long gtid, long gsize) {
    for (long it = gtid; it < (long)ntok * GH; it += gsize) {
        const int n = (int)(it / GH), h = (int)(it % GH);
        const float* o0 = p.GO + (size_t)n * GW + h * HD; const float* o1 = p.GO + ((size_t)NT + n) * GW + h * HD;
        const float* gate = p.PROJ + (size_t)n * PJS + 3 * GW + h * HD; const float* g = p.gdn_norm_g + l * HD;
        float v[HD]; float ss = 0.f;
#pragma unroll
        for (int d = 0; d < HD; ++d) { v[d] = o0[d] + o1[d]; ss += v[d] * v[d]; }
        const float rs = frsq(ss / HD + EPS); bf16_t* op = p.MIXb + (size_t)n * D + h * HD;
#pragma unroll
        for (int d = 0; d < HD; ++d) op[d] = f2bf(v[d] * rs * g[d] * siluf(gate[d]));
    }
    for (long it = gtid; it < (long)ntok * LW; it += gsize) {
        const int n = (int)(it / LW), c = (int)(it % LW);
        const int bb = n < NL ? n / SEQ : (n - NL) / CTX;
        float hs = 0.f;
#pragma unroll
        for (int d = 0; d < 2; ++d) { const size_t ix = ((size_t)d * NT + n) * LW + c; hs += p.LH[ix] + p.LA[ix] * p.CARRY[((size_t)(bb * 2 + d) * NCH + tok_chunk(n, d)) * LW + c]; }
        p.MIXb[(size_t)n * D + GW + c] = f2bf(hs * gelu_tanhf(p.PROJ[(size_t)n * PJS + O_L + LW + c]));
    }
}
DEV void ph_outproj(const P& p, int l, int ntok, long gtid, long gsize) {
    const float* W = p.w_out + (size_t)l * D * D;
    gemm_naive<false>(ntok / 4, D, D,
        [&](int m, const float*&, const float*&) { return p.MIXb + (size_t)m * D; }, W, nullptr, D,
        [&](int m, int n0, const float* acc, const float*) {
            const float* g1 = p.MOD + ((size_t)l * (NB + 1) + tok_modrow(m)) * 6 * D + 2 * D + n0; float* o = p.X + (size_t)m * D + n0;
            o[0] += g1[0] * acc[0]; o[1] += g1[1] * acc[1]; o[2] += g1[2] * acc[2]; o[3] += g1[3] * acc[3]; },
        gtid, gsize);
}
DEV void ph_route(const P& p, int l, int ntok, long gtid, long gsize) {
    for (long it = gtid; it < ntok; it += gsize) {
        const int n = (int)it; bf16_t* h = p.H2b + (size_t)n * H2S;
        norm_row(p, l, n, 1, h);
        float lg[NLOG];
#pragma unroll
        for (int j = 0; j < NG; ++j) lg[j] = p.moe_b_group[l * NG + j];
#pragma unroll
        for (int j = 0; j < NE; ++j) lg[NG + j] = p.moe_b_expert[l * NE + j];
        const float* wg = p.moe_w_group + (size_t)l * D * NG; const float* we = p.moe_w_expert + (size_t)l * D * NE;
        for (int k = 0; k < D; ++k) {
            const float hv = bf2f(h[k]);
#pragma unroll
            for (int j = 0; j < NG; ++j) lg[j] += hv * wg[k * NG + j];
#pragma unroll
            for (int j = 0; j < NE; ++j) lg[NG + j] += hv * we[k * NE + j];
        }
        int gi = 0; float gm = lg[0];
#pragma unroll
        for (int j = 1; j < NG; ++j) if (lg[j] > gm) { gm = lg[j]; gi = j; }
        float gs = 0.f;
#pragma unroll
        for (int j = 0; j < NG; ++j) gs += fexp(lg[j] - gm);
        const float pg = 1.f / gs;
        float e1 = -1e30f, e2 = -1e30f; int i1 = 0, i2 = 0;
#pragma unroll
        for (int g = 0; g < NG; ++g) if (g == gi) {
#pragma unroll
            for (int j = 0; j < EPG; ++j) { const float v = lg[NG + g * EPG + j]; if (v > e1) { e2 = e1; i2 = i1; e1 = v; i1 = j; } else if (v > e2) { e2 = v; i2 = j; } }
        }
        const float w2 = fexp(e2 - e1), inv = 1.f / (1.f + w2);
        const int ex0 = gi * EPG + i1, ex1 = gi * EPG + i2;
        p.RE[n * 2] = ex0; p.RE[n * 2 + 1] = ex1; p.RG[n * 2] = pg * inv; p.RG[n * 2 + 1] = pg * w2 * inv;
        atomicAdd(&p.CNT[ex0], 1); atomicAdd(&p.CNT[ex1], 1);
    }
}
DEV void ph_offsets(const P& p, long gtid, long gsize) {
    if (gtid == 0) {
        int off = 0;
        for (int e = 0; e < NE; ++e) { p.OFF[e * 32] = off; const int pad = (p.CNT[e] + MBLK - 1) / MBLK * MBLK; for (int b = off / MBLK; b < (off + pad) / MBLK; ++b) p.BLKE[b * 32] = e; off += pad; }
        p.OFF[NE * 32] = off;
        for (int b = off / MBLK; b < NBLK; ++b) p.BLKE[b * 32] = -1;
    }
}
DEV void ph_slots(const P& p, int ntok, long gtid, long gsize) {
    for (long e = gtid; e < NE; e += gsize) {
        int s = p.OFF[e * 32];
        for (int i = 0; i < ntok * 2; ++i) if (p.RE[i] == (int)e) { p.SLOT_TOK[s] = i >> 1; p.SLOT_OF[(size_t)i * 32] = s; ++s; }
        for (; s < p.OFF[(e + 1) * 32]; ++s) p.SLOT_TOK[s] = -1;
    }
}
DEV void ph_moe1(const P& p, int l, long gtid, long gsize) {
    gemm_naive<true>(NSLOT / 4, HID, D,
        [&](int m, const float*& B, const float*& B2) -> const bf16_t* {
            const int e = p.BLKE[(m / MBLK) * 32]; if (e < 0) return nullptr;
            B = p.moe_w1 + ((size_t)l * NE + e) * D * HID; B2 = p.moe_w3 + ((size_t)l * NE + e) * D * HID;
            const int t = p.SLOT_TOK[m]; return t < 0 ? nullptr : p.H2b + (size_t)t * H2S; },
        nullptr, nullptr, HID,
        [&](int m, int n0, const float* a1, const float* a3) { bf16_t* o = p.ACTb + (size_t)m * HID + n0;
#pragma unroll
            for (int j = 0; j < 4; ++j) o[j] = f2bf(siluf(a1[j]) * a3[j]); },
        gtid, gsize);
}
DEV void ph_moe2(const P& p, int l, long gtid, long gsize) {
    gemm_naive<false>(NSLOT / 4, D, HID,
        [&](int m, const float*& B, const float*&) -> const bf16_t* {
            const int e = p.BLKE[(m / MBLK) * 32]; if (e < 0) return nullptr;
            B = p.moe_w2 + ((size_t)l * NE + e) * HID * D;
            return p.SLOT_TOK[m] < 0 ? nullptr : p.ACTb + (size_t)m * HID; },
        nullptr, nullptr, D,
        [&](int m, int n0, const float* acc, const float*) { float* o = p.Y + (size_t)m * D + n0; o[0] = acc[0]; o[1] = acc[1]; o[2] = acc[2]; o[3] = acc[3]; },
        gtid, gsize);
}
DEV void ph_combine(const P& p, int l, int ntok, long gtid, long gsize) {
    for (long it = gtid; it < (long)ntok * D; it += gsize) {
        const int n = (int)(it / D), j = (int)(it % D);
        const float g2 = p.MOD[((size_t)l * (NB + 1) + tok_modrow(n)) * 6 * D + 5 * D + j];
        const float y = p.RG[n * 2] * p.Y[(size_t)p.SLOT_OF[(size_t)n * 64] * D + j] + p.RG[n * 2 + 1] * p.Y[(size_t)p.SLOT_OF[(size_t)n * 64 + 32] * D + j];
        p.X[it] += g2 * y;
    }
}
DEV void ph_final(const P& p, long gtid, long gsize) {
    for (long it = gtid; it < NL; it += gsize) {
        const float* xr = p.X + (size_t)it * D; float ss = 0.f;
        for (int k = 0; k < D; ++k) ss += xr[k] * xr[k];
        const float rs = frsq(ss / D + EPS);
        for (int k = 0; k < D; ++k) p.out[(size_t)it * D + k] = xr[k] * rs * p.final_norm_g[k];
    }
}


#ifndef HOST_EMU
#define LAS __attribute__((address_space(3)))
namespace pg8 {
typedef short bf16x8 __attribute__((ext_vector_type(8)));
typedef float f32x4 __attribute__((ext_vector_type(4)));
typedef unsigned u32x4 __attribute__((ext_vector_type(4)));
typedef unsigned u32x2 __attribute__((ext_vector_type(2)));
constexpr int BM = 256, BK = 64, HALF = 128, HTB = HALF * BK * 2, STAGE_BYTES = 8 * HTB, NXCD = 8, WGM = 8;
__device__ __forceinline__ int lds_byte(int r, int c) { const int st = (r >> 4) * 2 + (c >> 5), rr = r & 15, cc = c & 31, ob = rr * 64 + cc * 2; return st * 1024 + (ob ^ (((ob >> 9) & 1) << 5)); }
__device__ __forceinline__ void stage_rc(int b, int& R, int& C) { const int st = b / 1024, sb = b % 1024, swz = sb ^ (((sb >> 9) & 1) << 5); R = (st >> 1) * 16 + swz / 64; C = (st & 1) * 32 + (swz % 64) / 2; }
__device__ __forceinline__ int perm32(int rho) { const int n = rho >> 4, i = rho & 15; return 8 * (i >> 2) + 4 * n + (i & 3); }
typedef float f32x2c __attribute__((ext_vector_type(2))); typedef __bf16 bf16x2c __attribute__((ext_vector_type(2)));
__device__ __forceinline__ unsigned cvt_pk_bf16(float lo, float hi) { const f32x2c v = {lo, hi}; return __builtin_bit_cast(unsigned, __builtin_convertvector(v, bf16x2c)); }

struct Unit { int row0, col0; const char* B; const int* rows; int aoff; };

struct DenseSched {
    int nM, nN, nwg, G, c; const char* Bt; int K;
    __device__ void init(int M, int N, int K_, const void* Bt_, int G_, int c_) { nM = M / BM; nN = N / BM; nwg = nM * nN; G = G_; c = c_; Bt = (const char*)Bt_; K = K_; }
    __device__ bool next(int i, Unit& u) const {
        const long L = (long)i * G + c; if (L >= nwg) return false;
        int wgid = (int)L; { const int q = nwg / NXCD, r = nwg % NXCD, xcd = wgid % NXCD, off = wgid / NXCD; wgid = (xcd < r ? xcd * (q + 1) : r * (q + 1) + (xcd - r) * q) + off; }
        const int nig = WGM * nN, gid = wgid / nig, fm = gid * WGM, gsz = (nM - fm) < WGM ? (nM - fm) : WGM;
        const int pm = fm + ((wgid % nig) % gsz), pn = (wgid % nig) / gsz;
        u.row0 = pm * BM; u.col0 = pn * BM; u.B = Bt + (size_t)pn * BM * K * 2; u.rows = nullptr; u.aoff = 0; return true;
    }
};
struct MoeSched {
    int nunits, G, c; const char* W; size_t estride; int K; const int* blke; const int* rows;
    __device__ bool next(int i, Unit& u) const {
        const long L = (long)i * G + c; if (L >= nunits) return false;
        const int pm = (int)(L >> 2), pn = (int)(L & 3), e = __builtin_amdgcn_readfirstlane(blke[pm * 32 + VZ]);
        u.row0 = pm * BM; u.col0 = pn * BM; u.B = W + (size_t)e * estride + (size_t)pn * BM * K * 2; u.rows = rows ? rows + pm * BM : nullptr; u.aoff = 0; return true;
    }
};

template <class Epi, class Sched>
__device__ __forceinline__ void gemm_phase(LAS unsigned char* lds, const void* gA_, const int K, const int lda, const int ldb, const Sched& S, const Epi& E) {
    const char* gA = (const char*)gA_;
    int tid = threadIdx.x; asm volatile("" : "+v"(tid));
    const int wid = __builtin_amdgcn_readfirstlane(tid >> 6), lane = tid & 63, wr = wid >> 2, wc = wid & 3, fr = lane & 15, fq = lane >> 4;
    const int nt = K / BK;
    unsigned voffB[2];
#pragma unroll
    for (int i = 0; i < 2; ++i) { int R, C; stage_rc(tid * 16 + i * 8192, R, C); const int Rb = (R & ~31) + perm32(R & 31); voffB[i] = (unsigned)(Rb * ldb + C) * 2u; }
    LAS u32x4* park = (LAS u32x4*)(lds + 131072 + 64) + tid;
    const size_t kstep = (size_t)(BK * 2);
    const size_t hstepA = 0; (void)hstepA; const size_t hstep = (size_t)HALF * ldb * 2;
    const unsigned ldsw = (unsigned)wid * 1024u;
    const int aoff = lds_byte(wr * 64 + fr, fq * 8), boff = lds_byte(wc * 32 + fr, fq * 8);
#define PG8_SA(b, h) (((b) * 2 + (h)) * HTB)
#define PG8_SB(b, h) ((4 + (b) * 2 + (h)) * HTB)
#define PG8_STAGE_B(bufoff, gbase) do { _Pragma("unroll") for (int _i = 0; _i < 2; ++_i) \
        __builtin_amdgcn_global_load_lds((const unsigned*)((const char*)(gbase) + voffB[_i]), (LAS unsigned*)(lds + (bufoff) + ldsw + _i * 8192), 16, 0, 0); } while (0)
#define PG8_STAGE_A(bufoff, vo, kb) do { _Pragma("unroll") for (int _i = 0; _i < 2; ++_i) \
        __builtin_amdgcn_global_load_lds((const unsigned*)(gA + (kb) + (vo(_i))), (LAS unsigned*)(lds + (bufoff) + ldsw + _i * 8192), 16, 0, 0); } while (0)
#define VC0(i) vc[0][i]
#define VC1(i) vc[1][i]
#define V20(i) vc[0][i]
#define V21(i) vc[1][i]
#define PG8_LDA(dst, b, h) do { _Pragma("unroll") for (int m = 0; m < 4; ++m) _Pragma("unroll") for (int k = 0; k < 2; ++k) dst[m][k] = *(const LAS bf16x8*)(lds + PG8_SA(b, h) + aoff + m * 2048 + k * 1024); } while (0)
#define PG8_LDB(dst, b, h) do { _Pragma("unroll") for (int n = 0; n < 2; ++n) _Pragma("unroll") for (int k = 0; k < 2; ++k) dst[n][k] = *(const LAS bf16x8*)(lds + PG8_SB(b, h) + boff + n * 2048 + k * 1024); } while (0)
#define PG8_MMA(ai, bj, At, Bt) do { __builtin_amdgcn_s_setprio(1); _Pragma("unroll") for (int m = 0; m < 4; ++m) _Pragma("unroll") for (int n = 0; n < 2; ++n) _Pragma("unroll") for (int k = 0; k < 2; ++k) \
        acc[ai][bj][m][n] = __builtin_amdgcn_mfma_f32_16x16x32_bf16(Bt[n][k], At[m][k], acc[ai][bj][m][n], 0, 0, 0); __builtin_amdgcn_s_setprio(0); } while (0)
#define PG8_WAIT_V(n) asm volatile("s_waitcnt vmcnt(" #n ")" ::: "memory")
#define PG8_WAIT_L(n) asm volatile("s_waitcnt lgkmcnt(" #n ")" ::: "memory")
#define PG8_BAR __builtin_amdgcn_s_barrier()
#define PG8_SCHED __builtin_amdgcn_sched_barrier(0)
#define PG8_MKVO(u, vo) do { _Pragma("unroll") for (int _h = 0; _h < 2; ++_h) _Pragma("unroll") for (int _i = 0; _i < 2; ++_i) { int _R, _C; stage_rc(tid * 16 + _i * 8192, _R, _C); const int _r = _h * HALF + _R; \
        int _row; if ((u).rows) { _row = (u).rows[_r]; _row = _row < 0 ? 0 : _row; } else _row = (u).row0 + _r; (vo)[_h][_i] = (unsigned)_row * (unsigned)(lda * 2) + (unsigned)(_C * 2) + (unsigned)(u).aoff; } } while (0)
    Unit cur, nxt; int ui = 0;
    if (!S.next(0, cur)) return;
    unsigned vc[2][2];
    PG8_MKVO(cur, vc);
    f32x4 acc[2][2][4][2];
#pragma unroll
    for (int a = 0; a < 2; ++a)
#pragma unroll
        for (int b = 0; b < 2; ++b)
#pragma unroll
            for (int m = 0; m < 4; ++m)
#pragma unroll
                for (int n = 0; n < 2; ++n) acc[a][b][m][n] = (f32x4){0.f, 0.f, 0.f, 0.f};
    bf16x8 At[4][2], B0[2][2], B1[2][2];
    const char* cB = cur.B;
    PG8_STAGE_B(PG8_SB(0, 0), cB); PG8_STAGE_B(PG8_SB(0, 1), cB + hstep); PG8_STAGE_A(PG8_SA(0, 0), VC0, 0); PG8_STAGE_A(PG8_SA(0, 1), VC1, 0);
    if (wr == 1) PG8_BAR;
    PG8_WAIT_V(2); PG8_BAR;
    PG8_STAGE_B(PG8_SB(1, 0), cB + kstep); PG8_STAGE_A(PG8_SA(1, 0), VC0, kstep); PG8_STAGE_B(PG8_SB(1, 1), cB + hstep + kstep);
    PG8_WAIT_V(6); PG8_BAR;
    for (;;) {
        const bool has_next = S.next(ui + 1, nxt);
        { unsigned vt[2][2];
          if (has_next) { PG8_MKVO(nxt, vt); } else { vt[0][0] = vc[0][0]; vt[0][1] = vc[0][1]; vt[1][0] = vc[1][0]; vt[1][1] = vc[1][1]; }
          *park = (u32x4){vt[0][0], vt[0][1], vt[1][0], vt[1][1]}; }
        const char* nB = has_next ? nxt.B : cB;
#pragma unroll 1
        for (int t = 0; t < nt; t += 2) {
            const bool last = (t == nt - 2);
            const size_t ka1 = (size_t)(t + 1) * kstep;
            const size_t k2 = last ? 0 : (size_t)(t + 2) * kstep, k3 = k2 + kstep;
            const char* b2 = last ? nB : cB + (size_t)(t + 2) * kstep; const char* b3 = b2 + kstep;
            PG8_LDB(B0, 0, 0); PG8_LDB(B1, 0, 1); PG8_SCHED; PG8_LDA(At, 0, 0); PG8_STAGE_A(PG8_SA(1, 1), VC1, ka1);
            if (last) { const u32x4 pv = *park; vc[0][0] = pv.x; vc[0][1] = pv.y; vc[1][0] = pv.z; vc[1][1] = pv.w; }
            PG8_WAIT_V(8); PG8_WAIT_L(0); PG8_BAR; PG8_MMA(0, 0, At, B0); PG8_MMA(0, 1, At, B1); PG8_BAR; PG8_SCHED;
            PG8_LDA(At, 0, 1); PG8_STAGE_B(PG8_SB(0, 0), b2); PG8_STAGE_B(PG8_SB(0, 1), b2 + hstep); PG8_STAGE_A(PG8_SA(0, 0), V20, k2);
            PG8_WAIT_V(8); PG8_WAIT_L(0); PG8_BAR; PG8_MMA(1, 0, At, B0); PG8_MMA(1, 1, At, B1); PG8_BAR; PG8_SCHED;
            PG8_LDB(B0, 1, 0); PG8_LDB(B1, 1, 1); PG8_SCHED; PG8_LDA(At, 1, 0); PG8_STAGE_A(PG8_SA(0, 1), V21, k2);
            PG8_WAIT_V(8); PG8_WAIT_L(0); PG8_BAR; PG8_MMA(0, 0, At, B0); PG8_MMA(0, 1, At, B1); PG8_BAR; PG8_SCHED;
            PG8_LDA(At, 1, 1); PG8_STAGE_B(PG8_SB(1, 0), b3); PG8_STAGE_B(PG8_SB(1, 1), b3 + hstep); PG8_STAGE_A(PG8_SA(1, 0), V20, k3);
            PG8_WAIT_V(8); PG8_WAIT_L(0); PG8_BAR; PG8_MMA(1, 0, At, B0); PG8_MMA(1, 1, At, B1); PG8_BAR; PG8_SCHED;
        }
        if (wr == 0) PG8_BAR;
        E(acc, cur, wr, wc, fr, fq);
        if (!has_next) break;
#pragma unroll
        for (int a = 0; a < 2; ++a)
#pragma unroll
            for (int b = 0; b < 2; ++b)
#pragma unroll
                for (int m = 0; m < 4; ++m)
#pragma unroll
                    for (int n = 0; n < 2; ++n) acc[a][b][m][n] = (f32x4){0.f, 0.f, 0.f, 0.f};
        cur = nxt; cB = nB; ++ui;
        if (wr == 1) PG8_BAR;
    }
    PG8_WAIT_V(0);
    PG8_BAR;
#undef PG8_SA
#undef PG8_SB
#undef PG8_STAGE_A
#undef PG8_STAGE_B
#undef PG8_LDA
#undef PG8_LDB
#undef PG8_MMA
#undef PG8_WAIT_V
#undef PG8_WAIT_L
#undef PG8_BAR
#undef PG8_SCHED
#undef PG8_MKVO
#undef VC0
#undef VC1
#undef V20
#undef V21
}
struct EpiProj {
    bf16_t* O; float* AB;
    __device__ __forceinline__ void operator()(const f32x4 (&acc)[2][2][4][2], const Unit& u, int wr, int wc, int fr, int fq) const {
#pragma unroll
        for (int ai = 0; ai < 2; ++ai)
#pragma unroll
            for (int m = 0; m < 4; ++m) { const int r = u.row0 + ai * HALF + wr * 64 + m * 16 + fr;
#pragma unroll
                for (int bj = 0; bj < 2; ++bj) { const int c = u.col0 + bj * HALF + wc * 32 + 8 * fq; const f32x4 v0 = acc[ai][bj][m][0], v1 = acc[ai][bj][m][1];
                    if (c < PJ) { u32x4 w; w.x = cvt_pk_bf16(v0[0], v0[1]); w.y = cvt_pk_bf16(v0[2], v0[3]); w.z = cvt_pk_bf16(v1[0], v1[1]); w.w = cvt_pk_bf16(v1[2], v1[3]); *(u32x4*)(O + (size_t)r * NPJ + c) = w; }
                    if (c >= 4 * GW && c < 4 * GW + 4 * GH) { *(f32x4*)(AB + (size_t)r * 32 + (c - 4 * GW)) = v0; *(f32x4*)(AB + (size_t)r * 32 + (c - 4 * GW) + 4) = v1; } } }
    }
};
template <bool FIRST> struct EpiResid {
    float* X; const float* g; const float* xl; const float* xc;
    __device__ __forceinline__ void operator()(const f32x4 (&acc)[2][2][4][2], const Unit& u, int wr, int wc, int fr, int fq) const {
#pragma unroll
        for (int ai = 0; ai < 2; ++ai)
#pragma unroll
            for (int m = 0; m < 4; ++m) { const int r = u.row0 + ai * HALF + wr * 64 + m * 16 + fr; const float* gr = g + (size_t)tok_modrow(r) * 6 * D;
#pragma unroll
                for (int bj = 0; bj < 2; ++bj)
#pragma unroll
                    for (int n = 0; n < 2; ++n) { const int c = u.col0 + bj * HALF + wc * 32 + 8 * fq + 4 * n; f32x4* xp = (f32x4*)(X + (size_t)r * D + c); const f32x4 gv = *(const f32x4*)(gr + c);
                        const f32x4 xin = FIRST ? *(const f32x4*)((r < NL ? xl + (size_t)r * D : xc + (size_t)(r - NL) * D) + c) : *xp; *xp = xin + gv * acc[ai][bj][m][n]; } }
    }
};
struct EpiAct {
    bf16_t* O;
    __device__ __forceinline__ void operator()(const f32x4 (&acc)[2][2][4][2], const Unit& u, int wr, int wc, int fr, int fq) const {
#pragma unroll
        for (int ai = 0; ai < 2; ++ai)
#pragma unroll
            for (int m = 0; m < 4; ++m) { const int r = u.row0 + ai * HALF + wr * 64 + m * 16 + fr;
#pragma unroll
                for (int bj = 0; bj < 2; ++bj) { const int c = u.col0 + bj * HALF + wc * 32 + 8 * fq; const f32x4 v0 = acc[ai][bj][m][0], v1 = acc[ai][bj][m][1];
                    u32x2 w; w.x = cvt_pk_bf16(siluf(v0[0]) * v0[1], siluf(v0[2]) * v0[3]); w.y = cvt_pk_bf16(siluf(v1[0]) * v1[1], siluf(v1[2]) * v1[3]);
                    *(u32x2*)(O + (size_t)r * HID + (c >> 1)) = w; } }
    }
};
struct EpiY {
    bf16_t* O;
    __device__ __forceinline__ void operator()(const f32x4 (&acc)[2][2][4][2], const Unit& u, int wr, int wc, int fr, int fq) const {
#pragma unroll
        for (int ai = 0; ai < 2; ++ai)
#pragma unroll
            for (int m = 0; m < 4; ++m) { const int r = u.row0 + ai * HALF + wr * 64 + m * 16 + fr;
#pragma unroll
                for (int bj = 0; bj < 2; ++bj) { const int c = u.col0 + bj * HALF + wc * 32 + 8 * fq; const f32x4 v0 = acc[ai][bj][m][0], v1 = acc[ai][bj][m][1];
                    u32x4 w; w.x = cvt_pk_bf16(v0[0], v0[1]); w.y = cvt_pk_bf16(v0[2], v0[3]); w.z = cvt_pk_bf16(v1[0], v1[1]); w.w = cvt_pk_bf16(v1[2], v1[3]); *(u32x4*)(O + (size_t)r * D + c) = w; } }
    }
};
}

__device__ __forceinline__ void transpose_tile(const float* src, int sN, int Nvalid, int k0, int n0, bf16_t* dst, int K, int rmul, int roff, LAS unsigned char* lds) {
    LAS bf16_t* T = (LAS bf16_t*)lds;
    int t = threadIdx.x; asm volatile("" : "+v"(t));
    { const int kk = t >> 3, c8 = (t & 7) * 8; const float* sp = src + (size_t)(k0 + kk) * sN + n0 + c8;
#pragma unroll
      for (int j = 0; j < 8; ++j) { const float v = (n0 + c8 + j) < Nvalid ? sp[j] : 0.f; T[(c8 + j) * 66 + kk] = f2bf(v); } }
    __syncthreads();
    { const int nn = t >> 3, k8 = (t & 7) * 8; const LAS unsigned* tp = (const LAS unsigned*)(T + nn * 66 + k8);
      pg8::u32x4 w; w.x = tp[0]; w.y = tp[1]; w.z = tp[2]; w.w = tp[3];
      *(pg8::u32x4*)(dst + (size_t)((n0 + nn) * rmul + roff) * K + k0 + k8) = w; }
    __syncthreads();
}
__device__ __forceinline__ void ph_wprep(const P& p, LAS unsigned char* lds) {
    const int G = gridDim.x, c = blockIdx.x;
    for (int it = c; it < DEPTH * (D / 64) * (NPJ / 64); it += G) { const int l = it / ((D / 64) * (NPJ / 64)), r = it % ((D / 64) * (NPJ / 64)), kt = r / (NPJ / 64), ntl = r % (NPJ / 64);
        transpose_tile(p.w_in + (size_t)l * D * PJ, PJ, PJ, kt * 64, ntl * 64, p.WinT + (size_t)l * NPJ * D, D, 1, 0, lds); }
    for (int it = c; it < DEPTH * (D / 64) * (D / 64); it += G) { const int l = it / ((D / 64) * (D / 64)), r = it % ((D / 64) * (D / 64)), kt = r / (D / 64), ntl = r % (D / 64);
        transpose_tile(p.w_out + (size_t)l * D * D, D, D, kt * 64, ntl * 64, p.WoutT + (size_t)l * D * D, D, 1, 0, lds); }
}
constexpr int MOE_T13 = NE * 2 * (D / 64) * (HID / 64), MOE_TILES = MOE_T13 + NE * (HID / 64) * (D / 64);
__device__ __forceinline__ void moe_tile(const P& p, int l, int t, LAS unsigned char* lds) {
    if (t < MOE_T13) { const int per = (D / 64) * (HID / 64), le = l * NE + t / (2 * per), r = t % (2 * per), s3 = r / per, q = r % per, kt = q / (HID / 64), ntl = q % (HID / 64);
        transpose_tile((s3 ? p.moe_w3 : p.moe_w1) + (size_t)le * D * HID, HID, HID, kt * 64, ntl * 64, p.W13T + (size_t)le * 2 * HID * D, D, 2, s3, lds); }
    else { const int t2 = t - MOE_T13, per = (HID / 64) * (D / 64), le = l * NE + t2 / per, q = t2 % per, kt = q / (D / 64), ntl = q % (D / 64);
        transpose_tile(p.moe_w2 + (size_t)le * HID * D, D, D, kt * 64, ntl * 64, p.W2T + (size_t)le * D * HID, HID, 1, 0, lds); }
}
__device__ __forceinline__ void moe_batch4(const P& p, int l, int t0, LAS unsigned char* lds) {
    typedef float f32x4 __attribute__((ext_vector_type(4)));
    int t = threadIdx.x; HIDE(t);
    const int kk = t >> 3, c8 = (t & 7) * 8;
    f32x4 v[4][2];
#pragma unroll
    for (int j = 0; j < 4; ++j) { const int tt = t0 + j; const float* sp;
        if (tt < MOE_T13) { const int per = (D / 64) * (HID / 64), le = l * NE + tt / (2 * per), r = tt % (2 * per), s3 = r / per, q = r % per, kt = q / (HID / 64), ntl = q % (HID / 64);
            sp = (s3 ? p.moe_w3 : p.moe_w1) + (size_t)le * D * HID + (size_t)(kt * 64 + kk) * HID + ntl * 64 + c8; }
        else { const int t2 = tt - MOE_T13, per = (HID / 64) * (D / 64), le = l * NE + t2 / per, q = t2 % per, kt = q / (D / 64), ntl = q % (D / 64);
            sp = p.moe_w2 + (size_t)le * HID * D + (size_t)(kt * 64 + kk) * D + ntl * 64 + c8; }
        v[j][0] = *(const f32x4*)sp; v[j][1] = *(const f32x4*)(sp + 4); }
#pragma unroll
    for (int j = 0; j < 4; ++j) { LAS bf16_t* T = (LAS bf16_t*)(lds + j * 8704);
#pragma unroll
        for (int i = 0; i < 8; ++i) T[(c8 + i) * 66 + kk] = f2bf(v[j][i >> 2][i & 3]); }
    __syncthreads();
    const int nn = t >> 3, k8 = (t & 7) * 8;
#pragma unroll
    for (int j = 0; j < 4; ++j) { const int tt = t0 + j; bf16_t* dp;
        if (tt < MOE_T13) { const int per = (D / 64) * (HID / 64), le = l * NE + tt / (2 * per), r = tt % (2 * per), s3 = r / per, q = r % per, kt = q / (HID / 64), ntl = q % (HID / 64);
            dp = p.W13T + (size_t)le * 2 * HID * D + (size_t)((ntl * 64 + nn) * 2 + s3) * D + kt * 64 + k8; }
        else { const int t2 = tt - MOE_T13, per = (HID / 64) * (D / 64), le = l * NE + t2 / per, q = t2 % per, kt = q / (D / 64), ntl = q % (D / 64);
            dp = p.W2T + (size_t)le * D * HID + (size_t)(ntl * 64 + nn) * HID + kt * 64 + k8; }
        const LAS unsigned* tp = (const LAS unsigned*)((LAS bf16_t*)(lds + j * 8704) + nn * 66 + k8);
        pg8::u32x4 w; w.x = tp[0]; w.y = tp[1]; w.z = tp[2]; w.w = tp[3];
        *(pg8::u32x4*)dp = w; }
    __syncthreads();
}
__device__ __forceinline__ void wq_pull(const P& p, int l, int nbatch, LAS unsigned char* lds) {
    if (l >= DEPTH) return;
    unsigned* ctr = p.bar + 3712 + l * 32; LAS int* tq = (LAS int*)(lds + 131072 + 48);
    for (int k = 0; nbatch < 0 || k < nbatch; ++k) {
        __syncthreads();
        if (threadIdx.x == 0) *tq = (int)__hip_atomic_fetch_add(ctr, 4u, __ATOMIC_RELAXED, __HIP_MEMORY_SCOPE_AGENT);
        __syncthreads();
        const int t0 = __builtin_amdgcn_readfirstlane(*tq); if (t0 >= MOE_TILES) break;
        moe_batch4(p, l, t0, lds);
    }
}
__device__ __forceinline__ void ph_inproj_mfma(const P& p, int l, LAS unsigned char* lds) {
    pg8::DenseSched S; S.init(NT, NPJ, D, p.WinT + (size_t)l * NPJ * D, gridDim.x, blockIdx.x);
    pg8::EpiProj E{p.PROJb, p.AB};
    pg8::gemm_phase(lds, p.HNb, D, D, D, S, E);
}
__device__ __forceinline__ void ph_outproj_mfma(const P& p, int l, int ntok, LAS unsigned char* lds) {
    pg8::DenseSched S; S.init(ntok, D, D, p.WoutT + (size_t)l * D * D, gridDim.x, blockIdx.x);
    if (l == 0) { pg8::EpiResid<true> E{p.X, p.MOD + (size_t)l * (NB + 1) * 6 * D + 2 * D, p.x, p.ctx}; pg8::gemm_phase(lds, p.MIXb, D, D, D, S, E); }
    else { pg8::EpiResid<false> E{p.X, p.MOD + (size_t)l * (NB + 1) * 6 * D + 2 * D, nullptr, nullptr}; pg8::gemm_phase(lds, p.MIXb, D, D, D, S, E); }
}
__device__ __forceinline__ void ph_moe1_mfma(const P& p, int l, LAS unsigned char* lds) {
    pg8::MoeSched S{(__builtin_amdgcn_readfirstlane(p.OFF[NE * 32 + VZ]) / MBLK) * 4, (int)gridDim.x, (int)blockIdx.x, (const char*)(p.W13T + (size_t)l * NE * 2 * HID * D), (size_t)2 * HID * D * 2, D, p.BLKE, p.SLOT_TOK};
    pg8::EpiAct E{p.ACTb};
    pg8::gemm_phase(lds, p.H2b, D, H2S, D, S, E);
}
__device__ __forceinline__ void ph_moe2_mfma(const P& p, int l, LAS unsigned char* lds) {
    pg8::MoeSched S{(__builtin_amdgcn_readfirstlane(p.OFF[NE * 32 + VZ]) / MBLK) * 4, (int)gridDim.x, (int)blockIdx.x, (const char*)(p.W2T + (size_t)l * NE * D * HID), (size_t)D * HID * 2, HID, p.BLKE, nullptr};
    pg8::EpiY E{p.Yb};
    pg8::gemm_phase(lds, p.ACTb, HID, HID, HID, S, E);
}

namespace att {
typedef short bf16x8 __attribute__((ext_vector_type(8)));
typedef float f32x16 __attribute__((ext_vector_type(16)));
typedef unsigned u32x4 __attribute__((ext_vector_type(4)));
typedef unsigned u32x2 __attribute__((ext_vector_type(2)));
constexpr int KROW = 144, VROW = 136, KBUF = 64 * KROW, VBUF = 64 * VROW, VOFF = 2 * KBUF;
typedef float f32x2_t __attribute__((ext_vector_type(2))); typedef __bf16 bf16x2_t __attribute__((ext_vector_type(2)));
__device__ __forceinline__ unsigned pk(float lo, float hi) { const f32x2_t v = {lo, hi}; return __builtin_bit_cast(unsigned, __builtin_convertvector(v, bf16x2_t)); }
__device__ __forceinline__ float ex2(float x) { return __builtin_amdgcn_exp2f(x); }
__device__ __forceinline__ float max3f(float a, float b, float c) { float r; asm("v_max3_f32 %0, %1, %2, %3" : "=v"(r) : "v"(a), "v"(b), "v"(c)); return r; }
}
__device__ __forceinline__ void ph_attn_mfma(const P& p, int l, bool need_ctx, LAS unsigned char* lds) {
    using namespace att;
    int tid = threadIdx.x; HIDE(tid);
    const int wid = __builtin_amdgcn_readfirstlane(tid >> 6), lane = tid & 63, r32 = lane & 31, hh = lane >> 5, g = wid >> 1, tsub = wid & 1;
    const int srow = tid >> 3, schunk = tid & 7;
    constexpr int NLU = NB * AKH * (SEQ / 64), NCU = NB * AKH * (CTX / 64);
    const int nunits = NLU + (need_ctx ? NCU : 0);
    unsigned* qctr = p.bar + 3584 + l * 32; LAS int* uq = (LAS int*)(lds + 131072 + 32);
    for (;;) {
        __syncthreads();
        if (threadIdx.x == 0) *uq = (int)__hip_atomic_fetch_add(qctr, 1u, __ATOMIC_RELAXED, __HIP_MEMORY_SCOPE_AGENT);
        __syncthreads();
        const int u = *uq; if (u >= nunits) break;
        int b, kvh, tok0, kk0, ntiles;
        if (u < NLU) { b = u / (AKH * (SEQ / 64)); kvh = (u / (SEQ / 64)) % AKH; tok0 = b * SEQ + (u % (SEQ / 64)) * 64; kk0 = 0; ntiles = KK / 64; }
        else { const int v = u - NLU; b = v / (AKH * (CTX / 64)); kvh = (v / (CTX / 64)) % AKH; tok0 = NL + b * CTX + (v % (CTX / 64)) * 64; kk0 = SEQ; ntiles = CTX / 64; }
        const int hq = kvh * AG + g, token = tok0 + tsub * 32 + r32;
        bf16x8 qf[4];
        { const bf16_t* qrow = p.AQb + (size_t)token * AW + hq * HD + hh * 8;
#pragma unroll
          for (int s = 0; s < 4; ++s) qf[s] = *(const bf16x8*)(qrow + s * 16); }
        f32x16 o0, o1;
#pragma unroll
        for (int i = 0; i < 16; ++i) { o0[i] = 0.f; o1[i] = 0.f; }
        float m = -1e30f, lsum = 0.f;
        const bf16_t* Kg = p.Kc + ((size_t)(b * AKH + kvh) * KK + kk0 + srow) * HD + schunk * 8;
        const bf16_t* Vg = p.Vt + ((size_t)(b * AKH + kvh) * HD + srow) * KK + kk0 + schunk * 8;
        u32x4 kA = *(const u32x4*)Kg, vA = *(const u32x4*)Vg, kB = *(const u32x4*)(Kg + (size_t)64 * HD), vB = *(const u32x4*)(Vg + 64);
#define ATT_STORE(kr, vr, buf) do { LAS unsigned char* kb_ = lds + (buf) * KBUF + srow * KROW + schunk * 16; LAS unsigned char* vb_ = lds + VOFF + (buf) * VBUF + srow * VROW + schunk * 16; \
            *(LAS u32x4*)kb_ = (kr); *(LAS u32x2*)vb_ = (u32x2){(vr).x, (vr).y}; *(LAS u32x2*)(vb_ + 8) = (u32x2){(vr).z, (vr).w}; } while (0)
        ATT_STORE(kA, vA, 0);
        __syncthreads();
#define ATT_TILE(cur) do { \
            LAS unsigned char* Kb = lds + cur * KBUF; LAS unsigned char* Vb = lds + VOFF + cur * VBUF; \
            f32x16 s0, s1; \
_Pragma("unroll") \
            for (int i = 0; i < 16; ++i) { s0[i] = 0.f; s1[i] = 0.f; } \
_Pragma("unroll") \
            for (int s = 0; s < 4; ++s) { \
                const bf16x8 a0 = *(const LAS bf16x8*)(Kb + r32 * KROW + s * 32 + hh * 16), a1 = *(const LAS bf16x8*)(Kb + (r32 + 32) * KROW + s * 32 + hh * 16); \
                s0 = __builtin_amdgcn_mfma_f32_32x32x16_bf16(a0, qf[s], s0, 0, 0, 0); \
                s1 = __builtin_amdgcn_mfma_f32_32x32x16_bf16(a1, qf[s], s1, 0, 0, 0); \
            } \
            float mx = max3f(s0[0], s1[0], s0[1]); \
_Pragma("unroll") \
            for (int i = 1; i < 15; ++i) mx = max3f(mx, s1[i], s0[i + 1]); \
            mx = max3f(mx, s1[15], __shfl_xor(max3f(mx, s1[15], s1[15]), 32)); \
            if (__ballot(mx > m + 8.0f) != 0ull) {        \
                const float mn = max3f(m, mx, mx), alpha = ex2(m - mn); m = mn; lsum *= alpha; \
_Pragma("unroll") \
                for (int i = 0; i < 16; ++i) { o0[i] *= alpha; o1[i] *= alpha; } \
            } \
            float rs = 0.f; \
_Pragma("unroll") \
            for (int i = 0; i < 16; ++i) { s0[i] = ex2(s0[i] - m); s1[i] = ex2(s1[i] - m); rs += s0[i] + s1[i]; } \
            lsum += rs; \
            bf16x8 pf[4]; \
_Pragma("unroll") \
            for (int s = 0; s < 2; ++s) { \
                u32x4 w0, w1; \
                w0.x = pk(s0[8 * s + 0], s0[8 * s + 1]); w0.y = pk(s0[8 * s + 2], s0[8 * s + 3]); w0.z = pk(s0[8 * s + 4], s0[8 * s + 5]); w0.w = pk(s0[8 * s + 6], s0[8 * s + 7]); \
                w1.x = pk(s1[8 * s + 0], s1[8 * s + 1]); w1.y = pk(s1[8 * s + 2], s1[8 * s + 3]); w1.z = pk(s1[8 * s + 4], s1[8 * s + 5]); w1.w = pk(s1[8 * s + 6], s1[8 * s + 7]); \
                pf[s] = __builtin_bit_cast(bf16x8, w0); pf[2 + s] = __builtin_bit_cast(bf16x8, w1); \
            } \
_Pragma("unroll") \
            for (int t = 0; t < 2; ++t) \
_Pragma("unroll") \
                for (int s = 0; s < 2; ++s) { \
                    const int kb2 = (32 * t + 16 * s + 4 * hh) * 2; \
                    const LAS unsigned char* v0p = Vb + r32 * VROW + kb2; const LAS unsigned char* v1p = Vb + (r32 + 32) * VROW + kb2; \
                    const u32x2 l0 = *(const LAS u32x2*)v0p, h0 = *(const LAS u32x2*)(v0p + 16), l1 = *(const LAS u32x2*)v1p, h1 = *(const LAS u32x2*)(v1p + 16); \
                    const bf16x8 av0 = __builtin_bit_cast(bf16x8, (u32x4){l0.x, l0.y, h0.x, h0.y}), av1 = __builtin_bit_cast(bf16x8, (u32x4){l1.x, l1.y, h1.x, h1.y}); \
                    o0 = __builtin_amdgcn_mfma_f32_32x32x16_bf16(av0, pf[2 * t + s], o0, 0, 0, 0); \
                    o1 = __builtin_amdgcn_mfma_f32_32x32x16_bf16(av1, pf[2 * t + s], o1, 0, 0, 0); \
                } \
        } while (0)
        static_assert((KK / 64) % 2 == 0 && (CTX / 64) % 2 == 0, "the tile loop is unrolled by two");
        for (int j = 0; j < ntiles; j += 2) {
            if (j + 2 < ntiles) { kA = *(const u32x4*)(Kg + (size_t)(j + 2) * 64 * HD); vA = *(const u32x4*)(Vg + (j + 2) * 64); }
            ATT_TILE(0);
            ATT_STORE(kB, vB, 1);
            __syncthreads();
            if (j + 3 < ntiles) { kB = *(const u32x4*)(Kg + (size_t)(j + 3) * 64 * HD); vB = *(const u32x4*)(Vg + (j + 3) * 64); }
            ATT_TILE(1);
            if (j + 2 < ntiles) ATT_STORE(kA, vA, 0);
            __syncthreads();
        }
#undef ATT_TILE
#undef ATT_STORE
        lsum += __shfl_xor(lsum, 32);
        const float inv = 1.0f / lsum;
        bf16_t* op = p.MIXb + (size_t)token * D + GW + LW + hq * HD + 4 * hh;
#pragma unroll
        for (int q = 0; q < 4; ++q) {
            *(u32x2*)(op + 8 * q) = (u32x2){pk(o0[4 * q] * inv, o0[4 * q + 1] * inv), pk(o0[4 * q + 2] * inv, o0[4 * q + 3] * inv)};
            *(u32x2*)(op + 32 + 8 * q) = (u32x2){pk(o1[4 * q] * inv, o1[4 * q + 1] * inv), pk(o1[4 * q + 2] * inv, o1[4 * q + 3] * inv)};
        }
    }
}
constexpr int NCP = NB * GH * 2 * NCH;
__device__ __forceinline__ int frag_off(int i, int k) { return ((((i >> 5) * 4 + (k >> 4)) * 64 + (((k >> 2) & 1) * 32 + (i & 31))) * 8) + ((k >> 3) & 1) * 4 + (k & 3); }
__device__ __forceinline__ att::bf16x8 cvt8(const float* q) {
    const pg8::f32x4 a = *(const pg8::f32x4*)q, b = *(const pg8::f32x4*)(q + 4);
    att::u32x4 w; w.x = att::pk(a[0], a[1]); w.y = att::pk(a[2], a[3]); w.z = att::pk(b[0], b[1]); w.w = att::pk(b[2], b[3]);
    return __builtin_bit_cast(att::bf16x8, w);
}
__device__ __forceinline__ att::bf16x8 pack8(const att::f32x16& v, int o) {
    att::u32x4 w; w.x = att::pk(v[o], v[o + 1]); w.y = att::pk(v[o + 2], v[o + 3]); w.z = att::pk(v[o + 4], v[o + 5]); w.w = att::pk(v[o + 6], v[o + 7]);
    return __builtin_bit_cast(att::bf16x8, w);
}
template <int I> __device__ __forceinline__ void gdn_solve_block(float (&x)[64], const LAS float* At) {
#pragma unroll
    for (int j = 0; j < 16 * I; ++j) {
        const LAS pg8::f32x4* ap = (const LAS pg8::f32x4*)(At + j * 64 + 16 * I);
        const float xj = x[j];
#pragma unroll
        for (int q = 0; q < 4; ++q) { const pg8::f32x4 a4 = ap[q]; x[16 * I + 4 * q] -= a4[0] * xj; x[16 * I + 4 * q + 1] -= a4[1] * xj; x[16 * I + 4 * q + 2] -= a4[2] * xj; x[16 * I + 4 * q + 3] -= a4[3] * xj; }
    }
#pragma unroll
    for (int r2 = 0; r2 < 15; ++r2) {
        const LAS pg8::f32x4* ap = (const LAS pg8::f32x4*)(At + (16 * I + r2) * 64 + 16 * I);
#pragma unroll
        for (int q = 0; q < 4; ++q) { if (4 * q + 3 > r2) { const pg8::f32x4 a4 = ap[q];
#pragma unroll
            for (int e = 0; e < 4; ++e) if (4 * q + e > r2) x[16 * I + 4 * q + e] -= a4[e] * x[16 * I + r2]; } }
    }
}
template <int PASS> __device__ __forceinline__ void gdn_pass(LAS float* At, const LAS int* nL, const LAS float* btL, const LAS float* egL, const bf16_t* colbase, float* Uo, bf16_t* Wo, int lane) {
    asm volatile("" ::: "memory");
    float x[64];
#pragma unroll
    for (int i = 0; i < 64; ++i) { const bf16_t* row = colbase + (size_t)nL[i] * 3 * GW; x[i] = PASS ? btL[i] * egL[i] * bf2f(row[GW]) : btL[i] * bf2f(row[2 * GW]); }
    gdn_solve_block<0>(x, At); gdn_solve_block<1>(x, At); gdn_solve_block<2>(x, At); gdn_solve_block<3>(x, At);
    const int r32 = lane & 31, hh = lane >> 5;
    if (PASS == 0) {
#pragma unroll
        for (int i = 0; i < 64; i += 4) { const int rr = i & 31;
            *(pg8::f32x4*)(Uo + (((i >> 5) * 2 + hh) * 64 + (((rr >> 2) & 1) * 32 + r32)) * 16 + 4 * (rr >> 3)) = (pg8::f32x4){x[i], x[i + 1], x[i + 2], x[i + 3]}; }
    } else {
        LAS bf16_t* T = (LAS bf16_t*)At;
#pragma unroll
        for (int i = 0; i < 64; ++i) T[frag_off(i, lane)] = f2bf(-x[i]);
#pragma unroll
        for (int c = 0; c < 8; ++c) *(pg8::u32x4*)(Wo + (c * 64 + lane) * 8) = *(const LAS pg8::u32x4*)(T + (c * 64 + lane) * 8);
    }
}
__device__ __forceinline__ void ph_gdn_a(const P& p, int l, LAS unsigned char* lds) {
    using namespace att;
    int tid = threadIdx.x; HIDE(tid);
    const int wid = __builtin_amdgcn_readfirstlane(tid >> 6);
    LAS float* At = (LAS float*)(lds + wid * 16384);
    LAS float* gcL = (LAS float*)(lds + 131072 + 64 + wid * 1024);
    LAS float* btL = gcL + 64; LAS float* egL = gcL + 128; LAS int* nL = (LAS int*)(gcL + 192);
    const int per_wg = (NCP + (int)gridDim.x - 1) / (int)gridDim.x;
    for (int q = wid; q < per_wg; q += 8) { const int cp = blockIdx.x * per_wg + q; if (cp >= NCP) break;
        int lane = tid & 63; HIDE(lane);
        const int r32 = lane & 31, hh = lane >> 5;
        const int ci = cp % NCH, dir = (cp / NCH) % 2, h = (cp / (2 * NCH)) % GH, b = cp / (2 * NCH * GH);
        const int n = chunk_tok(b, dir, ci, lane);
        const float bt = p.GB[(size_t)n * 2 * GH + dir * GH + h];
        float gc = p.GG[(size_t)n * 2 * GH + dir * GH + h];
#pragma unroll
        for (int off = 1; off < 64; off <<= 1) { const float t = __shfl_up(gc, off); if (lane >= off) gc += t; }
        const float gl = __shfl(gc, 63);
        gcL[lane] = gc; btL[lane] = bt; egL[lane] = fexp(gc); nL[lane] = n;
        bf16x8 kf[2][4], qf[2][4];
#pragma unroll
        for (int blk = 0; blk < 2; ++blk) { const int nr = __shfl(n, blk * 32 + r32); const bf16_t* base = (const bf16_t*)p.GQKV + (size_t)nr * 3 * GW + h * HD + 8 * hh;
#pragma unroll
            for (int s = 0; s < 4; ++s) { qf[blk][s] = *(const bf16x8*)(base + 16 * s); kf[blk][s] = *(const bf16x8*)(base + GW + 16 * s); } }
        bf16_t* QKo = p.GQK + (size_t)cp * 4096;
#pragma unroll
        for (int tl = 0; tl < 3; ++tl) {
            const int rb = tl > 0, cb = tl > 1;
            f32x16 ak, aq;
#pragma unroll
            for (int i = 0; i < 16; ++i) { ak[i] = 0.f; aq[i] = 0.f; }
#pragma unroll
            for (int s = 0; s < 4; ++s) { ak = __builtin_amdgcn_mfma_f32_32x32x16_bf16(kf[rb][s], kf[cb][s], ak, 0, 0, 0); aq = __builtin_amdgcn_mfma_f32_32x32x16_bf16(qf[rb][s], kf[cb][s], aq, 0, 0, 0); }
            const int j = cb * 32 + r32; const float gcj = gcL[j];
#pragma unroll
            for (int r = 0; r < 16; ++r) {
                const int i = rb * 32 + (r & 3) + 8 * (r >> 2) + 4 * hh;
                const float dec = fexp(j <= i ? gcL[i] - gcj : 0.f);
                At[j * 64 + i] = j < i ? btL[i] * ak[r] * dec : 0.f;
                QKo[frag_off(i, j)] = f2bf(j <= i ? aq[r] * dec : 0.f);
            }
        }
        float* Uo = p.GU + (size_t)cp * 4096; bf16_t* Wo = p.GWN + (size_t)cp * 4096; bf16_t* QGo = p.GQG + (size_t)cp * 4096; bf16_t* KTo = p.GKT + (size_t)cp * 4096;
        const bf16_t* colbase = (const bf16_t*)p.GQKV + h * HD + lane;
        gdn_pass<0>(At, nL, btL, egL, colbase, Uo, Wo, lane); gdn_pass<1>(At, nL, btL, egL, colbase, Uo, Wo, lane);
#pragma unroll 1
        for (int i0 = 0; i0 < 64; i0 += 16) {
            float qv[16], kv[16];
#pragma unroll
            for (int i = 0; i < 16; ++i) { const bf16_t* row = colbase + (size_t)nL[i0 + i] * 3 * GW; qv[i] = bf2f(row[0]); kv[i] = bf2f(row[GW]); }
#pragma unroll
            for (int i = 0; i < 16; ++i) { ((LAS bf16_t*)At)[frag_off(i0 + i, lane)] = f2bf(qv[i] * egL[i0 + i]); kv[i] *= fexp(gl - gcL[i0 + i]); }
#pragma unroll
            for (int i = 0; i < 16; i += 4) *(att::u32x2*)(KTo + frag_off(lane, i0 + i)) = (att::u32x2){att::pk(kv[i], kv[i + 1]), att::pk(kv[i + 2], kv[i + 3])};
        }
#pragma unroll
        for (int c = 0; c < 8; ++c) *(pg8::u32x4*)(QGo + (c * 64 + lane) * 8) = *(const LAS pg8::u32x4*)((LAS bf16_t*)At + (c * 64 + lane) * 8);
        if (lane == 0) p.GEL[(size_t)cp * 32] = fexp(gl);
    }
}
__device__ __forceinline__ void ph_gdn_b(const P& p, int l, LAS unsigned char* lds) {
    using namespace att;
    if (blockIdx.x >= NB * GH * 2 * 2) return;
    int tid = threadIdx.x; HIDE(tid);
    const int wid = __builtin_amdgcn_readfirstlane(tid >> 6), lane = tid & 63, r32 = lane & 31, hh = lane >> 5;
    const int wv = blockIdx.x, slice = wv & 1, pr = wv >> 1, dir = pr & 1, h = (pr >> 1) % GH, b = pr / (2 * GH);
    constexpr int SLOT = 40960;
#define GB_ISSUE(ci_, slot_) do { _Pragma("unroll") for (int i_ = 0; i_ < 6; ++i_) { int k_ = (wid - 1) * 6 + i_; k_ = k_ > 39 ? 39 : k_; \
        const size_t cp_ = (size_t)pr * NCH + (ci_); const char* g_; \
        if (k_ < 32) g_ = (const char*)((k_ < 8 ? p.GWN : k_ < 16 ? p.GQG : k_ < 24 ? p.GQK : p.GKT) + cp_ * 4096) + (size_t)(k_ & 7) * 1024 + lane * 16; \
        else g_ = (const char*)(p.GU + cp_ * 4096 + ((((k_ - 32) >> 2) * 2 + slice) * 64 + lane) * 16) + ((k_ - 32) & 3) * 16; \
        __builtin_amdgcn_global_load_lds((const unsigned*)g_, (LAS unsigned*)(lds + (slot_) * SLOT + k_ * 1024), 16, 0, 0); } } while (0)
    f32x16 S0, S1;
#pragma unroll
    for (int i = 0; i < 16; ++i) { S0[i] = 0.f; S1[i] = 0.f; }
    float ev = 0.f;
    if (wid == 0) { if (lane < NCH) ev = p.GEL[((size_t)pr * NCH + lane) * 32]; }
    else { GB_ISSUE(0, 0); GB_ISSUE(1, 1); asm volatile("s_waitcnt vmcnt(6)" ::: "memory"); }
    for (int ci = 0; ci < NCH; ++ci) {
        __builtin_amdgcn_s_barrier(); asm volatile("" ::: "memory");
        if (wid != 0) {
            if (ci + 2 < NCH) { const int sl = (ci + 2) % 3; GB_ISSUE(ci + 2, sl); asm volatile("s_waitcnt vmcnt(6)" ::: "memory"); }
            else asm volatile("s_waitcnt vmcnt(0)" ::: "memory");
            continue;
        }
        const LAS unsigned char* sb = lds + (ci % 3) * SLOT + lane * 16;
#define GB_FR(mat, idx) (*(const LAS bf16x8*)(sb + ((mat) * 8 + (idx)) * 1024))
        f32x16 x0, x1;
#pragma unroll
        for (int q = 0; q < 4; ++q) { const pg8::f32x4 a0 = *(const LAS pg8::f32x4*)(sb + (32 + q) * 1024), a1 = *(const LAS pg8::f32x4*)(sb + (36 + q) * 1024);
            x0[4 * q] = a0[0]; x0[4 * q + 1] = a0[1]; x0[4 * q + 2] = a0[2]; x0[4 * q + 3] = a0[3]; x1[4 * q] = a1[0]; x1[4 * q + 1] = a1[1]; x1[4 * q + 2] = a1[2]; x1[4 * q + 3] = a1[3]; }
        const float e = __builtin_bit_cast(float, __builtin_amdgcn_readlane(__builtin_bit_cast(int, ev), ci));
        bf16x8 sf[4]; sf[0] = pack8(S0, 0); sf[1] = pack8(S0, 8); sf[2] = pack8(S1, 0); sf[3] = pack8(S1, 8);
        f32x16 t0, t1;
#pragma unroll
        for (int i = 0; i < 16; ++i) { t0[i] = 0.f; t1[i] = 0.f; }
#pragma unroll
        for (int s2 = 0; s2 < 4; ++s2) {
            x0 = __builtin_amdgcn_mfma_f32_32x32x16_bf16(GB_FR(0, s2), sf[s2], x0, 0, 0, 0); x1 = __builtin_amdgcn_mfma_f32_32x32x16_bf16(GB_FR(0, 4 + s2), sf[s2], x1, 0, 0, 0);
            t0 = __builtin_amdgcn_mfma_f32_32x32x16_bf16(GB_FR(1, s2), sf[s2], t0, 0, 0, 0); t1 = __builtin_amdgcn_mfma_f32_32x32x16_bf16(GB_FR(1, 4 + s2), sf[s2], t1, 0, 0, 0);
        }
        bf16x8 xf[4]; xf[0] = pack8(x0, 0); xf[1] = pack8(x0, 8); xf[2] = pack8(x1, 0); xf[3] = pack8(x1, 8);
        t0 = __builtin_amdgcn_mfma_f32_32x32x16_bf16(GB_FR(2, 0), xf[0], t0, 0, 0, 0); t0 = __builtin_amdgcn_mfma_f32_32x32x16_bf16(GB_FR(2, 1), xf[1], t0, 0, 0, 0);
#pragma unroll
        for (int s2 = 0; s2 < 4; ++s2) t1 = __builtin_amdgcn_mfma_f32_32x32x16_bf16(GB_FR(2, 4 + s2), xf[s2], t1, 0, 0, 0);
#pragma unroll
        for (int i = 0; i < 16; ++i) { S0[i] *= e; S1[i] *= e; }
#pragma unroll
        for (int s2 = 0; s2 < 4; ++s2) { S0 = __builtin_amdgcn_mfma_f32_32x32x16_bf16(GB_FR(3, s2), xf[s2], S0, 0, 0, 0); S1 = __builtin_amdgcn_mfma_f32_32x32x16_bf16(GB_FR(3, 4 + s2), xf[s2], S1, 0, 0, 0); }
        float* go = p.GO + (size_t)dir * NT * GW + h * HD + slice * 32 + r32;
#pragma unroll
        for (int r = 0; r < 16; ++r) {
            const int c = (r & 3) + 8 * (r >> 2) + 4 * hh;
            go[(size_t)chunk_tok(b, dir, ci, c) * GW] = t0[r]; go[(size_t)chunk_tok(b, dir, ci, 32 + c) * GW] = t1[r];
        }
    }
    __builtin_amdgcn_s_barrier(); asm volatile("" ::: "memory");
#undef GB_ISSUE
#undef GB_FR
}
__device__ __forceinline__ pg8::f32x4 ldb4(const bf16_t* q) { const pg8::u32x2 w = *(const pg8::u32x2*)q; return (pg8::f32x4){__builtin_bit_cast(float, w.x << 16), __builtin_bit_cast(float, w.x & 0xffff0000u), __builtin_bit_cast(float, w.y << 16), __builtin_bit_cast(float, w.y & 0xffff0000u)}; }
__device__ __forceinline__ float wave_sum(float v) {
#pragma unroll
    for (int o = 32; o > 0; o >>= 1) v += __shfl_xor(v, o);
    return v;
}
__device__ __forceinline__ void ph_rownorm(const P& p, int l, int lc, int ntok_c, int nrows) {
    typedef float f32x4 __attribute__((ext_vector_type(4)));
    typedef unsigned u32x2 __attribute__((ext_vector_type(2)));
    int tid = threadIdx.x; HIDE(tid);
    const int lane = tid & 63, wave = blockIdx.x * 8 + (tid >> 6), nwaves = gridDim.x * 8;
    constexpr int R = 3;
    for (int nb = wave * R; nb < nrows; nb += nwaves * R) {
        f32x4 x[R][D / 256], ya[R][D / 256], yb[R][D / 256]; float g0[R], g1[R]; bool comb[R]; int mr[R];
#pragma unroll
        for (int r = 0; r < R; ++r) { const int n = nb + r < nrows ? nb + r : nrows - 1; mr[r] = tok_modrow(n); comb[r] = lc >= 0 && n < ntok_c;
#pragma unroll
            for (int j = 0; j < D / 256; ++j) x[r][j] = *(const f32x4*)((lc < 0 ? (n < NL ? p.x + (size_t)n * D : p.ctx + (size_t)(n - NL) * D) : p.X + (size_t)n * D) + j * 256 + lane * 4); }
        int s0[R], s1[R];
#pragma unroll
        for (int r = 0; r < R; ++r) { const int n = nb + r < nrows ? nb + r : nrows - 1; const int vz = VZ;
            if (comb[r]) { s0[r] = p.SLOT_OF[(size_t)n * 64 + vz]; s1[r] = p.SLOT_OF[(size_t)n * 64 + 32 + vz]; g0[r] = p.RG[n * 2 + vz]; g1[r] = p.RG[n * 2 + 1 + vz]; } else { s0[r] = 0; s1[r] = 0; g0[r] = 0.f; g1[r] = 0.f; } }
#pragma unroll
        for (int r = 0; r < R; ++r)
#pragma unroll
            for (int j = 0; j < D / 256; ++j) { const int o = j * 256 + lane * 4; if (comb[r]) { ya[r][j] = ldb4(p.Yb + (size_t)s0[r] * D + o); yb[r][j] = ldb4(p.Yb + (size_t)s1[r] * D + o); } else { ya[r][j] = (f32x4){0.f, 0.f, 0.f, 0.f}; yb[r][j] = ya[r][j]; } }
#pragma unroll
        for (int r = 0; r < R; ++r) {
            const int n = nb + r; if (n >= nrows) break;
            if (comb[r]) { const float* g2 = p.MOD + ((size_t)lc * (NB + 1) + mr[r]) * 6 * D + 5 * D;
#pragma unroll
                for (int j = 0; j < D / 256; ++j) { const int o = j * 256 + lane * 4; const f32x4 g = *(const f32x4*)(g2 + o); x[r][j] = x[r][j] + g * (ya[r][j] * g0[r] + yb[r][j] * g1[r]); if (l < DEPTH) *(f32x4*)(p.X + (size_t)n * D + o) = x[r][j]; } }
            float ss = 0.f;
#pragma unroll
            for (int j = 0; j < D / 256; ++j) ss += x[r][j][0] * x[r][j][0] + x[r][j][1] * x[r][j][1] + x[r][j][2] * x[r][j][2] + x[r][j][3] * x[r][j][3];
            const float rs = frsq(wave_sum(ss) * (1.0f / D) + EPS);
            if (l < DEPTH) {
                const float* gn = p.norm1_g + l * D; const float* md = p.MOD + ((size_t)l * (NB + 1) + mr[r]) * 6 * D;
#pragma unroll
                for (int j = 0; j < D / 256; ++j) { const int o = j * 256 + lane * 4; const f32x4 g = *(const f32x4*)(gn + o), sh = *(const f32x4*)(md + o), sc = *(const f32x4*)(md + D + o);
                    const f32x4 h = x[r][j] * rs * g * (sc + 1.0f) + sh;
                    *(u32x2*)(p.HNb + (size_t)n * D + o) = (u32x2){att::pk(h[0], h[1]), att::pk(h[2], h[3])}; }
            } else {
#pragma unroll
                for (int j = 0; j < D / 256; ++j) { const int o = j * 256 + lane * 4; const f32x4 g = *(const f32x4*)(p.final_norm_g + o); *(f32x4*)(p.out + (size_t)n * D + o) = x[r][j] * rs * g; }
            }
        }
    }
}
constexpr int MOD_KS = 8;
__device__ __forceinline__ void ph_mod_part(const P& p, LAS unsigned char* lds) {
    int tid = threadIdx.x; HIDE(tid);
    LAS float* SL = (LAS float*)lds;
    for (int i = tid; i < (NB + 1) * D; i += 512) { const int r = i / D, k = i % D; SL[i] = siluf(r < NB ? p.c[r * D + k] : p.c_ctx[k]); }
    __syncthreads();
    for (int it = blockIdx.x * 512 + tid; it < DEPTH * MOD_KS * 6 * D; it += gridDim.x * 512) {
        const int j = it % (6 * D), ks = (it / (6 * D)) % MOD_KS, l = it / (6 * D * MOD_KS);
        float acc[NB + 1];
#pragma unroll
        for (int r = 0; r <= NB; ++r) acc[r] = 0.f;
        const float* w = p.w_ada + ((size_t)l * D + ks * (D / MOD_KS)) * 6 * D + j;
#pragma unroll 8
        for (int k = 0; k < D / MOD_KS; ++k) { const float wv = w[(size_t)k * 6 * D];
#pragma unroll
            for (int r = 0; r <= NB; ++r) acc[r] += SL[r * D + ks * (D / MOD_KS) + k] * wv; }
#pragma unroll
        for (int r = 0; r <= NB; ++r) p.PART[(((size_t)ks * DEPTH + l) * (NB + 1) + r) * 6 * D + j] = acc[r];
    }
    __syncthreads();
}
__device__ __forceinline__ void ph_mod_reduce(const P& p) {
    int tid = threadIdx.x; HIDE(tid);
    for (int it = blockIdx.x * 512 + tid; it < DEPTH * (NB + 1) * 6 * D; it += gridDim.x * 512) {
        const int j = it % (6 * D), l = it / (6 * D * (NB + 1));
        float a = p.b_ada[l * 6 * D + j];
#pragma unroll
        for (int ks = 0; ks < MOD_KS; ++ks) a += p.PART[(size_t)ks * DEPTH * (NB + 1) * 6 * D + it];
        p.MOD[it] = a;
    }
}
__device__ __forceinline__ void ph_norm2_w(const P& p, int l, int ntok) {
    typedef float f32x4 __attribute__((ext_vector_type(4)));
    typedef unsigned u32x2 __attribute__((ext_vector_type(2)));
    int tid = threadIdx.x; HIDE(tid);
    const int lane = tid & 63, wave = blockIdx.x * 8 + (tid >> 6), nwaves = gridDim.x * 8;
    constexpr int R = 3;
    for (int nb = wave * R; nb < ntok; nb += nwaves * R) {
        f32x4 x[R][D / 256];
#pragma unroll
        for (int r = 0; r < R; ++r) { const int n = nb + r < ntok ? nb + r : ntok - 1;
#pragma unroll
            for (int j = 0; j < D / 256; ++j) x[r][j] = *(const f32x4*)(p.X + (size_t)n * D + j * 256 + lane * 4); }
#pragma unroll
        for (int r = 0; r < R; ++r) {
            const int n = nb + r; if (n >= ntok) break;
            float ss = 0.f;
#pragma unroll
            for (int j = 0; j < D / 256; ++j) ss += x[r][j][0] * x[r][j][0] + x[r][j][1] * x[r][j][1] + x[r][j][2] * x[r][j][2] + x[r][j][3] * x[r][j][3];
            const float rs = frsq(wave_sum(ss) * (1.0f / D) + EPS);
            const float* gn = p.norm2_g + l * D; const float* md = p.MOD + ((size_t)l * (NB + 1) + tok_modrow(n)) * 6 * D + 3 * D;
            bf16_t* hb = p.H2b + (size_t)n * H2S;
#pragma unroll
            for (int j = 0; j < D / 256; ++j) { const int o = j * 256 + lane * 4; const f32x4 g = *(const f32x4*)(gn + o), sh = *(const f32x4*)(md + o), sc = *(const f32x4*)(md + D + o);
                const f32x4 h = x[r][j] * rs * g * (sc + 1.0f) + sh;
                const u32x2 hi = (u32x2){att::pk(h[0], h[1]), att::pk(h[2], h[3])};
                const float r0 = h[0] - __builtin_bit_cast(float, hi.x << 16), r1 = h[1] - __builtin_bit_cast(float, hi.x & 0xffff0000u), r2 = h[2] - __builtin_bit_cast(float, hi.y << 16), r3 = h[3] - __builtin_bit_cast(float, hi.y & 0xffff0000u);
                const u32x2 lo = (u32x2){att::pk(r0, r1), att::pk(r2, r3)};
                *(u32x2*)(hb + o) = hi; *(u32x2*)(hb + D + o) = lo; }
        }
    }
}
__device__ __forceinline__ void ph_wr_prep(const P& p) {
    int tid = threadIdx.x; HIDE(tid);
    for (int it = blockIdx.x * 512 + tid; it < DEPTH * 256 * D; it += gridDim.x * 512) {
        const int k = it % D, j = (it / D) % 256, l = it / (D * 256);
        float w = 0.f; if (j < NG) w = p.moe_w_group[((size_t)l * D + k) * NG + j]; else if (j < NLOG) w = p.moe_w_expert[((size_t)l * D + k) * NE + (j - NG)];
        const bf16_t hi = f2bf(w), lo = f2bf(w - bf2f(hi));
        bf16_t* o = p.WrT + ((size_t)l * 256 + j) * H2S + k; o[0] = hi; o[D] = hi; o[2 * D] = lo;
    }
}
namespace pg8 {
struct EpiLogit {
    float* O;
    __device__ __forceinline__ void operator()(const f32x4 (&acc)[2][2][4][2], const Unit& u, int wr, int wc, int fr, int fq) const {
#pragma unroll
        for (int ai = 0; ai < 2; ++ai)
#pragma unroll
            for (int m = 0; m < 4; ++m) { const int r = u.row0 + ai * HALF + wr * 64 + m * 16 + fr;
#pragma unroll
                for (int n = 0; n < 2; ++n) { const int c = wc * 32 + 8 * fq + 4 * n; if (c < NLOG) *(f32x4*)(O + (size_t)r * 128 + c) = acc[ai][0][m][n]; } }
    }
};
}
namespace pg8 {
struct RouteSched {
    int nunits, G, c; const char* Bt;
    __device__ bool next(int i, Unit& u) const {
        const long L = (long)i * G + c; if (L >= nunits) return false;
        const int pm = (int)(L / 3), part = (int)(L % 3);
        u.row0 = pm * BM; u.col0 = part; u.B = Bt + (size_t)part * D * 2; u.rows = nullptr; u.aoff = (part == 2 ? 0 : part) * D * 2; return true;
    }
};
struct EpiLogitP {
    float* O;
    __device__ __forceinline__ void operator()(const f32x4 (&acc)[2][2][4][2], const Unit& u, int wr, int wc, int fr, int fq) const {
        float* Op = O + (size_t)u.col0 * NT * 128;
#pragma unroll
        for (int ai = 0; ai < 2; ++ai)
#pragma unroll
            for (int m = 0; m < 4; ++m) { const int r = u.row0 + ai * HALF + wr * 64 + m * 16 + fr;
#pragma unroll
                for (int n = 0; n < 2; ++n) { const int c = wc * 32 + 8 * fq + 4 * n; if (c < NLOG) *(f32x4*)(Op + (size_t)r * 128 + c) = acc[ai][0][m][n]; } }
    }
};
}
__device__ __forceinline__ void ph_rgemm(const P& p, int l, int ntok, LAS unsigned char* lds) {
    pg8::RouteSched S{(ntok / 256) * 3, (int)gridDim.x, (int)blockIdx.x, (const char*)(p.WrT + (size_t)l * 256 * H2S)};
    pg8::EpiLogitP E{p.LOGIT};
    pg8::gemm_phase(lds, p.H2b, D, H2S, H2S, S, E);
}
__device__ __forceinline__ void ph_topk(const P& p, int l, int ntok, LAS unsigned char* lds) {
    int tid = threadIdx.x; HIDE(tid);
    LAS int* hist = (LAS int*)lds;
    if (tid < NE) hist[tid] = 0;
    __syncthreads();
    for (int chunk = blockIdx.x + (tid >> 6) * gridDim.x; chunk * 64 < ntok; chunk += 8 * gridDim.x) { const int n = chunk * 64 + (tid & 63);
    if (n < ntok) {
        const float* lg = p.LOGIT + (size_t)n * 128; const float* lg1 = lg + (size_t)NT * 128; const float* lg2 = lg1 + (size_t)NT * 128;
        float g[NG]; int gi = 0;
#pragma unroll
        for (int j = 0; j < NG; ++j) g[j] = ((lg[j] + lg1[j]) + lg2[j]) + p.moe_b_group[l * NG + j];
        float gm = g[0];
#pragma unroll
        for (int j = 1; j < NG; ++j) if (g[j] > gm) { gm = g[j]; gi = j; }
        float gs = 0.f;
#pragma unroll
        for (int j = 0; j < NG; ++j) gs += fexp(g[j] - gm);
        float e1 = -1e30f, e2 = -1e30f; int i1 = 0, i2 = 0;
#pragma unroll
        for (int j = 0; j < EPG; ++j) { const float v = ((lg[NG + gi * EPG + j] + lg1[NG + gi * EPG + j]) + lg2[NG + gi * EPG + j]) + p.moe_b_expert[l * NE + gi * EPG + j]; if (v > e1) { e2 = e1; i2 = i1; e1 = v; i1 = j; } else if (v > e2) { e2 = v; i2 = j; } }
        const float w2 = fexp(e2 - e1), inv = 1.f / (1.f + w2), pg = 1.f / gs;
        const int ex0 = gi * EPG + i1, ex1 = gi * EPG + i2;
        p.RE[n * 2] = ex0; p.RE[n * 2 + 1] = ex1; p.RG[n * 2] = pg * inv; p.RG[n * 2 + 1] = pg * w2 * inv;
        __hip_atomic_fetch_add(hist + ex0, 1, __ATOMIC_RELAXED, __HIP_MEMORY_SCOPE_WORKGROUP); __hip_atomic_fetch_add(hist + ex1, 1, __ATOMIC_RELAXED, __HIP_MEMORY_SCOPE_WORKGROUP);
    } }
    __syncthreads();
    if (tid < NE) { const int c = hist[tid]; if (c) atomicAdd(&p.CNT[tid], c); }
    __syncthreads();
}
__device__ __forceinline__ void ph_slots_off_w(const P& p, int ntok) {
    int tid = threadIdx.x; HIDE(tid);
    const int lane = tid & 63, e = blockIdx.x * 8 + (tid >> 6);
    if (e >= NE) return;
    const int padl = (p.CNT[lane] + MBLK - 1) / MBLK * MBLK;
    int incl = padl;
#pragma unroll
    for (int o = 1; o < 64; o <<= 1) { const int t = __shfl_up(incl, o); if (lane >= o) incl += t; }
    const int total = __shfl(incl, 63), end = __shfl(incl, e), off = end - __shfl(padl, e);
    if (lane == 0) { p.OFF[e * 32] = off; if (e == NE - 1) p.OFF[NE * 32] = total; }
    for (int b = off / MBLK + lane; b < end / MBLK; b += 64) p.BLKE[b * 32] = e;
    if (e == NE - 1) for (int b = total / MBLK + lane; b < NBLK; b += 64) p.BLKE[b * 32] = -1;
    int run = 0;
    for (int base = 0; base < ntok * 2; base += 512) {
        int ex[8];
#pragma unroll
        for (int q = 0; q < 8; ++q) ex[q] = p.RE[base + q * 64 + lane];
#pragma unroll
        for (int q = 0; q < 8; ++q) {
            const int i = base + q * 64 + lane; const bool m = ex[q] == e;
            const unsigned long long mask = __ballot(m);
            if (m) { const int s2 = off + run + __popcll(mask & ((1ull << lane) - 1ull)); p.SLOT_TOK[s2] = i >> 1; p.SLOT_OF[(size_t)i * 32] = s2; }
            run += __popcll(mask);
        }
    }
    for (int s2 = off + run + lane; s2 < end; s2 += 64) p.SLOT_TOK[s2] = -1;
}
__device__ __forceinline__ void ph_wl_prep(const P& p) {
    int tid = threadIdx.x; HIDE(tid);
    for (int it = blockIdx.x * 512 + tid; it < DEPTH * 4 * LW * LW; it += gridDim.x * 512) {
        const int k = it % LW, nn = (it / LW) % (4 * LW), l = it / (LW * 4 * LW);
        const int dir = nn / (2 * LW), c = (nn % (2 * LW)) >> 1, gate = nn & 1;
        float w = 0.f;
        if (k / LBW == c / LBW) w = (gate ? p.lru_w_i : p.lru_w_r)[(((size_t)(l * 2 + dir) * 4 + c / LBW) * LBW + k % LBW) * LBW + c % LBW];
        p.WlT[it] = f2bf(w);
    }
}
namespace pg8 {
struct EpiLru {
    float* LA; float* LBX;
    __device__ __forceinline__ void operator()(const f32x4 (&acc)[2][2][4][2], const Unit& u, int wr, int wc, int fr, int fq) const {
#pragma unroll
        for (int bj = 0; bj < 2; ++bj) {
            const int col = u.col0 + bj * HALF + wc * 32 + 8 * fq, dir = col / (2 * LW), c0 = (col % (2 * LW)) >> 1;
#pragma unroll
            for (int ai = 0; ai < 2; ++ai)
#pragma unroll
                for (int m = 0; m < 4; ++m) { const int r = u.row0 + ai * HALF + wr * 64 + m * 16 + fr;
                    const f32x4 v0 = acc[ai][bj][m][0], v1 = acc[ai][bj][m][1];
                    *(u32x2*)((bf16_t*)LA + ((size_t)dir * NT + r) * LW + c0) = (u32x2){cvt_pk_bf16(v0[0], v0[2]), cvt_pk_bf16(v1[0], v1[2])}; *(u32x2*)((bf16_t*)LBX + ((size_t)dir * NT + r) * LW + c0) = (u32x2){cvt_pk_bf16(v0[1], v0[3]), cvt_pk_bf16(v1[1], v1[3])}; }
        }
    }
};
}
__device__ __forceinline__ void ph_lru_gates(const P& p, int l, LAS unsigned char* lds) {
    pg8::DenseSched S; S.init(NT, 4 * LW, LW, p.WlT + (size_t)l * 4 * LW * LW, gridDim.x, blockIdx.x);
    pg8::EpiLru E{p.LA, p.LBX};
    pg8::gemm_phase(lds, p.LXRb, LW, LW, LW, S, E);
}
__device__ __forceinline__ void ph_lru_scan(const P& p, int l) {
    int tid = threadIdx.x; HIDE(tid);
    if (tid < 64) return;
    bf16_t* LHb = (bf16_t*)p.LH; bf16_t* LAb = LHb + (size_t)2 * NT * LW;
    for (int it = blockIdx.x * 448 + (tid - 64); it < NB * 2 * NCH * LW; it += gridDim.x * 448) {
        const int c = it % LW, ci = (it / LW) % NCH, dir = (it / (LW * NCH)) % 2, b = it / (LW * NCH * 2);
        const float br = p.lru_b_r[(l * 2 + dir) * LW + c], bi = p.lru_b_i[(l * 2 + dir) * LW + c], sp = -8.0f * softplusf(-p.lru_lambda[(l * 2 + dir) * LW + c]);
        float h = 0.f, A = 1.f;
        for (int i0 = 0; i0 < 64; i0 += 16) {
            float pa[16], pb[16], px[16]; size_t ixs[16];
#pragma unroll
            for (int i = 0; i < 16; ++i) { const int n = chunk_tok(b, dir, ci, i0 + i); ixs[i] = ((size_t)dir * NT + n) * LW + c; pa[i] = bf2f(((const bf16_t*)p.LA)[ixs[i]]); pb[i] = bf2f(((const bf16_t*)p.LBX)[ixs[i]]); px[i] = bf2f(p.LXRb[(size_t)n * LW + c]); }
#pragma unroll
            for (int i = 0; i < 16; ++i) {
                const float la = sigmoidf(pa[i] + br) * sp, a = fexp(la), bx = __builtin_amdgcn_sqrtf(neg_expm1f(2.0f * la)) * (sigmoidf(pb[i] + bi) * px[i]);
                h = a * h + bx; A *= a; LHb[ixs[i]] = f2bf(h); LAb[ixs[i]] = f2bf(A);
            }
        }
    }
}
__device__ __forceinline__ void ph_prep_w(const P& p, int l) {
    typedef float f32x4 __attribute__((ext_vector_type(4)));
    typedef unsigned u32x2 __attribute__((ext_vector_type(2)));
    typedef unsigned u32x4 __attribute__((ext_vector_type(4)));
    int tid = threadIdx.x; HIDE(tid);
    const int lane = tid & 63, wave = blockIdx.x * 8 + (tid >> 6), nwaves = gridDim.x * 8;
    for (int n = wave; n < NT; n += nwaves) {
        int s0, len; tok_seg(n, s0, len);
        const bf16_t* pr = p.PROJb + (size_t)n * NPJ;
        f32x4 vq[3];
#pragma unroll
        for (int which = 0; which < 3; ++which) {
            const int c0 = which * GW + lane * 4;
            const float* w = p.gdn_conv_w + (size_t)l * 4 * 3 * GW + c0;
            f32x4 acc = (f32x4){0.f, 0.f, 0.f, 0.f};
#pragma unroll
            for (int j = 0; j < 4; ++j) { const int m = n + j - 1; if (m >= s0 && m < s0 + len) acc = acc + *(const f32x4*)(w + j * 3 * GW) * ldb4(p.PROJb + (size_t)m * NPJ + c0); }
            f32x4 v; v[0] = siluf(acc[0]); v[1] = siluf(acc[1]); v[2] = siluf(acc[2]); v[3] = siluf(acc[3]);
            if (which < 2) {
                float ss = v[0] * v[0] + v[1] * v[1] + v[2] * v[2] + v[3] * v[3];
                ss += __shfl_xor(ss, 1); ss += __shfl_xor(ss, 2); ss += __shfl_xor(ss, 4); ss += __shfl_xor(ss, 8);
                v = v * (frsq(ss + EPS) * (which == 0 ? 0.125f : 1.0f));
            }
            vq[which] = v;
        }
        const int lg = lane & (2 * GH - 1);
        const float al = p.AB[(size_t)n * 32 + lg], be = p.AB[(size_t)n * 32 + 2 * GH + lg];
        const float gg = -fexp(p.gdn_a_log[l * 2 * GH + lg]) * softplusf(al + p.gdn_dt_bias[l * 2 * GH + lg]), gb = sigmoidf(be);
        f32x4 lacc;
        {
            const int c0 = lane * 4; const float* w = p.lru_conv_w + (size_t)l * 4 * LW + c0;
            f32x4 acc = *(const f32x4*)(p.lru_conv_b + l * LW + c0);
#pragma unroll
            for (int j = 0; j < 4; ++j) { const int m = n + j - 1; if (m >= s0 && m < s0 + len) acc = acc + *(const f32x4*)(w + j * LW) * ldb4(p.PROJb + (size_t)m * NPJ + O_L + c0); }
            lacc = acc;
        }
        const int b = n < NL ? n / SEQ : (n - NL) / CTX, kk = n < NL ? n % SEQ : SEQ + (n - NL) % CTX;
        const float* rt = p.ROPE + (size_t)(n < NL ? n % SEQ : 0) * 64;
        u32x4 wqk[2];
#pragma unroll
        for (int isk = 0; isk < 2; ++isk) {
            const int ls = isk ? (lane & 15) : lane, d0 = (ls & 7) * 8;
            const bf16_t* src = pr + O_A + (isk ? AW : 0) + ls * 8; const float* g = (isk ? p.attn_k_norm_g : p.attn_q_norm_g) + l * HD + d0;
            const f32x4 a0 = ldb4(src), a1 = ldb4(src + 4);
            float x[8] = {a0[0], a0[1], a0[2], a0[3], a1[0], a1[1], a1[2], a1[3]};
            float ss = 0.f;
#pragma unroll
            for (int e = 0; e < 8; ++e) ss += x[e] * x[e];
            ss += __shfl_xor(ss, 1); ss += __shfl_xor(ss, 2); ss += __shfl_xor(ss, 4);
            const float rs = frsq(ss * (1.0f / HD) + EPS);
#pragma unroll
            for (int e = 0; e < 8; ++e) x[e] = x[e] * rs * g[e];
            if (n < NL) {
                const int second = (ls >> 1) & 1, half = (ls >> 2) & 1, i0 = (ls & 1) * 8;
#pragma unroll
                for (int e = 0; e < 8; ++e) { const float other = __shfl_xor(x[e], 2), cs = rt[half * 32 + i0 + e], sn = rt[half * 32 + 16 + i0 + e];
                    x[e] = second ? other * sn + x[e] * cs : x[e] * cs - other * sn; }
            }
            const float qs = isk ? 1.0f : QSCALE;
            wqk[isk] = (u32x4){att::pk(x[0] * qs, x[1] * qs), att::pk(x[2] * qs, x[3] * qs), att::pk(x[4] * qs, x[5] * qs), att::pk(x[6] * qs, x[7] * qs)};
        }
#pragma unroll
        for (int which = 0; which < 3; ++which) *(u32x2*)((bf16_t*)p.GQKV + (size_t)n * 3 * GW + which * GW + lane * 4) = (u32x2){att::pk(vq[which][0], vq[which][1]), att::pk(vq[which][2], vq[which][3])};
        if (lane < 2 * GH) { p.GG[(size_t)n * 2 * GH + lane] = gg; p.GB[(size_t)n * 2 * GH + lane] = gb; }
        *(u32x2*)(p.LXRb + (size_t)n * LW + lane * 4) = (u32x2){att::pk(lacc[0], lacc[1]), att::pk(lacc[2], lacc[3])};
        *(u32x4*)(p.AQb + (size_t)n * AW + lane * 8) = wqk[0];
        if (lane < 16) *(u32x4*)(p.Kc + ((size_t)(b * AKH + (lane >> 3)) * KK + kk) * HD + (lane & 7) * 8) = wqk[1];
    }
    for (int it = blockIdx.x * 512 + tid; it < NB * AKH * (KK / 64) * HD * 4; it += gridDim.x * 512) {
        const int d = it % HD, qtr = (it / HD) % 4, rest = it / (HD * 4), kb = rest % (KK / 64), kvh = (rest / (KK / 64)) % AKH, b = rest / ((KK / 64) * AKH);
        const int n0 = (kb * 64 < SEQ ? b * SEQ + kb * 64 : NL + b * CTX + (kb * 64 - SEQ)) + qtr * 16;
        const bf16_t* vsrc = p.PROJb + (size_t)n0 * NPJ + O_A + AW + KVW + kvh * HD + d;
        bf16_t* vb = p.Vt + ((size_t)(b * AKH + kvh) * HD + d) * KK + kb * 64 + qtr * 16;
        unsigned w[8];
#pragma unroll
        for (int i = 0; i < 8; ++i) w[i] = (unsigned)vsrc[(size_t)(2 * i) * NPJ] | ((unsigned)vsrc[(size_t)(2 * i + 1) * NPJ] << 16);
        *(u32x4*)vb = (u32x4){w[0], w[1], w[2], w[3]}; *(u32x4*)(vb + 8) = (u32x4){w[4], w[5], w[6], w[7]};
    }
}
__device__ __forceinline__ void ph_readout_w(const P& p, int l, int ntok) {
    typedef float f32x4 __attribute__((ext_vector_type(4)));
    typedef unsigned u32x2 __attribute__((ext_vector_type(2)));
    int tid = threadIdx.x; HIDE(tid);
    const int lane = tid & 63, wave = blockIdx.x * 8 + (tid >> 6), nwaves = gridDim.x * 8, c0 = lane * 4;
    for (int n = wave; n < ntok; n += nwaves) {
        const bf16_t* pr = p.PROJb + (size_t)n * NPJ;
        u32x2 wg;
        {   const f32x4 v = *(const f32x4*)(p.GO + (size_t)n * GW + c0) + *(const f32x4*)(p.GO + ((size_t)NT + n) * GW + c0);
            float ss = v[0] * v[0] + v[1] * v[1] + v[2] * v[2] + v[3] * v[3];
            ss += __shfl_xor(ss, 1); ss += __shfl_xor(ss, 2); ss += __shfl_xor(ss, 4); ss += __shfl_xor(ss, 8);
            const float rs = frsq(ss * (1.0f / HD) + EPS);
            const f32x4 g = *(const f32x4*)(p.gdn_norm_g + l * HD + (c0 & (HD - 1))), gate = ldb4(pr + 3 * GW + c0);
            wg = (u32x2){att::pk(v[0] * rs * g[0] * siluf(gate[0]), v[1] * rs * g[1] * siluf(gate[1])), att::pk(v[2] * rs * g[2] * siluf(gate[2]), v[3] * rs * g[3] * siluf(gate[3]))};
        }
        {   const int bb = n < NL ? n / SEQ : (n - NL) / CTX;
            f32x4 hs = (f32x4){0.f, 0.f, 0.f, 0.f};
#pragma unroll
            for (int d = 0; d < 2; ++d) { const size_t ix = ((size_t)d * NT + n) * LW + c0;
                hs = hs + ldb4((const bf16_t*)p.LH + ix) + ldb4((const bf16_t*)p.LH + (size_t)2 * NT * LW + ix) * *(const f32x4*)(p.CARRY + ((size_t)(bb * 2 + d) * NCH + tok_chunk(n, d)) * LW + c0); }
            const f32x4 y = ldb4(pr + O_L + LW + c0);
            *(u32x2*)(p.MIXb + (size_t)n * D + c0) = wg;
            *(u32x2*)(p.MIXb + (size_t)n * D + GW + c0) = (u32x2){att::pk(hs[0] * gelu_tanhf(y[0]), hs[1] * gelu_tanhf(y[1])), att::pk(hs[2] * gelu_tanhf(y[2]), hs[3] * gelu_tanhf(y[3]))};
        }
    }
}
#endif


#ifdef HOST_EMU
#define WQ(minblk, nb)
#define HOSTB true
#define GTID0 ((int)gtid0)
#define LOADP
typedef int LdsPtr;
#define DO_WPREP
#define DO_INIT ph_init(p, gtid, gsize)
#define DO_INPROJ ph_inproj(p, l, gtid, gsize)
#define DO_OUTPROJ ph_outproj(p, l, ntok, gtid, gsize)
#define DO_MOE1 ph_moe1(p, l, gtid, gsize)
#define DO_MOE2 ph_moe2(p, l, gtid, gsize)
#define DO_ATTN ph_attn(p, l, ntok, gtid, gsize)
#define DO_GDN_A
#define DO_GDN_B ph_gdn_naive(p, l, gtid, gsize)
#define DO_MOD ph_mod(p, gtid, gsize)
#define DO_COMBINE_OR_MODRED if (l > 0) ph_combine(p, l - 1, ntok_prev, gtid, gsize)
#define DO_NORM1 ph_norm1(p, l, gtid, gsize)
#define DO_PREP ph_prep(p, l, gtid, gsize)
#define DO_LRU_CARRY ph_lru_carry(p, gtid, gsize)
#define DO_READOUT ph_readout(p, l, ntok, gtid, gsize)
#define DO_LRU_GATES
#define DO_LRU_LOCAL ph_lru_local(p, l, gtid, gsize)
#define DO_ROUTE ph_route(p, l, ntok, gtid, gsize)
#define DO_ROUTE2
#define DO_ROUTE3
#define DO_OFFSETS ph_offsets(p, gtid, gsize)
#define DO_SLOTS ph_slots(p, ntok, gtid, gsize)
#define DO_FINAL_COMBINE ph_combine(p, DEPTH - 1, NL, gtid, gsize)
#define DO_FINAL ph_final(p, gtid, gsize)
#else
#define HOSTB false
#define GTID0 ((int)(blockIdx.x * 512 + threadIdx.x))
typedef LAS unsigned char* LdsPtr;
typedef const __attribute__((address_space(4))) P* KernArgP;
#define LOADP P p_; { KernArgP k_ = (KernArgP)__builtin_amdgcn_kernarg_segment_ptr(); asm volatile("" : "+s"(k_)); const __attribute__((address_space(4))) unsigned long long* q_ = (const __attribute__((address_space(4))) unsigned long long*)k_; void** d_ = (void**)&p_; _Pragma("unroll") for (int i_ = 0; i_ < (int)(sizeof(P) / 8); ++i_) d_[i_] = (void*)(__attribute__((address_space(1))) void*)q_[i_]; }     const P& p = p_;
#ifndef MFMA_DENSE
#define MFMA_DENSE 1
#endif
#ifndef MFMA_MOE
#define MFMA_MOE 1
#endif
#define DO_INIT
#define DO_WPREP ph_wprep(p, lds); ph_wr_prep(p); ph_wl_prep(p); wq_pull(p, 0, -1, lds)
#define WQ(minblk, nb) do { if ((int)blockIdx.x >= (minblk)) wq_pull(p, l + 1, (nb), lds); } while (0)
#define DO_MOD ph_mod_part(p, lds)
#define DO_COMBINE_OR_MODRED if (l == 0) ph_mod_reduce(p)
#define DO_NORM1 ph_norm1_aux(p, gtid, gsize); ph_rownorm(p, l, l - 1, NT, NT)
#define DO_PREP ph_prep_w(p, l)
#define DO_LRU_CARRY ph_lru_carry_w(p, gtid - 128 * 512 < 0 ? gsize : gtid - 128 * 512, gsize)
#define DO_READOUT ph_readout_w(p, l, ntok)
#define DO_LRU_GATES ph_lru_gates(p, l, lds)
#define DO_LRU_LOCAL ph_lru_scan(p, l)
#define DO_ROUTE ph_norm2_w(p, l, ntok)
#define DO_ROUTE2 ph_rgemm(p, l, ntok, lds)
#define DO_ROUTE3 ph_topk(p, l, ntok, lds)
#define DO_OFFSETS
#define DO_SLOTS ph_slots_off_w(p, ntok)
#define DO_FINAL_COMBINE
#define DO_FINAL ph_rownorm(p, DEPTH, DEPTH - 1, NL, NL)
#ifndef MFMA_GDN
#define MFMA_GDN 1
#endif
#if MFMA_GDN
#define DO_GDN_A ph_gdn_a(p, l, lds)
#define DO_GDN_B ph_gdn_b(p, l, lds)
#else
#define DO_GDN_A
#define DO_GDN_B ph_gdn_naive(p, l, gtid, gsize)
#endif
#ifndef MFMA_ATTN
#define MFMA_ATTN 1
#endif
#if MFMA_ATTN
#define DO_ATTN ph_attn_mfma(p, l, ntok == NT, lds)
#else
#define DO_ATTN ph_attn(p, l, ntok, gtid, gsize)
#endif
#if MFMA_DENSE
#define DO_INPROJ ph_inproj_mfma(p, l, lds)
#define DO_OUTPROJ ph_outproj_mfma(p, l, ntok, lds)
#else
#define DO_INPROJ ph_inproj(p, l, gtid, gsize)
#define DO_OUTPROJ ph_outproj(p, l, ntok, gtid, gsize)
#endif
#if MFMA_MOE
#define DO_MOE1 ph_moe1_mfma(p, l, lds)
#define DO_MOE2 ph_moe2_mfma(p, l, lds)
#else
#define DO_MOE1 ph_moe1(p, l, gtid, gsize)
#define DO_MOE2 ph_moe2(p, l, gtid, gsize)
#endif
#endif
template <bool ALL, class BarFn>
DEV void run_phases(const P& p, int ph_lo, int ph_hi, long gtid0, long gsize, LdsPtr lds, BarFn bar) {
    int ph = 0;
#define PHASE(body) do { if (ALL || (ph >= ph_lo && ph < ph_hi)) { int gt_ = GTID0; HIDE(gt_); const long gtid = gt_; { LOADP; body; } if (ALL || ph + 1 < ph_hi) bar(); } if (!ALL) ++ph; } while (0)
#define PHASE_IF(cond, body) do { if (cond) PHASE(body); } while (0)
    PHASE({ DO_MOD; DO_INIT; ph_rope(p, gtid, gsize); DO_WPREP; });
#define LAYER(L_) if (L_ < DEPTH) { constexpr int l = L_; \
        const int ntok = l < DEPTH - 1 ? NT : NL;         \
        const int ntok_prev = l - 1 < DEPTH - 1 ? NT : NL; \
        PHASE_IF(HOSTB || l == 0, { DO_COMBINE_OR_MODRED; }); \
        PHASE({ DO_NORM1; }); \
        PHASE({ DO_INPROJ; }); \
        PHASE({ DO_PREP; }); \
        PHASE_IF(!HOSTB, { DO_LRU_GATES; }); \
        PHASE({ DO_GDN_A; DO_LRU_LOCAL; }); \
        PHASE({ DO_GDN_B; DO_LRU_CARRY; DO_ATTN; }); \
        PHASE({ DO_READOUT; }); \
        PHASE({ DO_OUTPROJ; WQ(32, 5); }); \
        PHASE({ DO_ROUTE; }); \
        PHASE_IF(!HOSTB, { DO_ROUTE2; WQ(216, 3); }); \
        PHASE_IF(!HOSTB, { DO_ROUTE3; WQ(0, 3); }); \
        PHASE_IF(HOSTB, { DO_OFFSETS; }); \
        PHASE({ DO_SLOTS; WQ(8, -1); }); \
        PHASE({ DO_MOE1; }); \
        PHASE({ DO_MOE2; }); \
    }
    LAYER(0) LAYER(1) LAYER(2) LAYER(3)
#undef LAYER
    static_assert(DEPTH <= 4, "LAYER instances");
    PHASE_IF(HOSTB, { DO_FINAL_COMBINE; });
    { int gt_ = GTID0; HIDE(gt_); const long gtid = gt_; if (ALL || (ph >= ph_lo && ph < ph_hi)) { LOADP; DO_FINAL; } }
#undef PHASE
}
constexpr int TOTAL_PHASES = 1 + 13 * DEPTH + 2;

struct Carver { char* base; size_t off; template <class T> T* take(size_t n) { off = (off + 255) & ~(size_t)255; T* r = (T*)(base + off); off += n * sizeof(T); return r; } };
static inline size_t carve(P& p, void* ws) {
    Carver c{(char*)ws, 0};
    p.bar = c.take<unsigned>(4096);
    p.CNT = c.take<int>(NE); p.OFF = c.take<int>((NE + 1) * 32); p.BLKE = c.take<int>(NBLK * 32);
    p.X = c.take<float>((size_t)NT * D); p.ROPE = c.take<float>((size_t)SEQ * 64); p.PART = c.take<float>((size_t)8 * DEPTH * (NB + 1) * 6 * D); p.CARRY = c.take<float>((size_t)NB * 2 * NCH * LW); p.MOD = c.take<float>((size_t)DEPTH * (NB + 1) * 6 * D); p.HNb = c.take<bf16_t>((size_t)NT * D);
#ifdef HOST_EMU
    p.PROJ = c.take<float>((size_t)NT * PJS); p.AQ = c.take<float>((size_t)NT * AW); p.AK = c.take<float>((size_t)NT * KVW); p.Y = c.take<float>((size_t)NSLOT * D);
#endif
    p.GQKV = c.take<float>((size_t)NT * 3 * GW); p.GG = c.take<float>((size_t)NT * 2 * GH); p.GB = c.take<float>((size_t)NT * 2 * GH);
    p.GO = c.take<float>((size_t)2 * NT * GW); p.LXR = c.take<float>((size_t)NT * LW); p.LA = c.take<float>((size_t)2 * NT * LW);
    p.LH = c.take<float>((size_t)2 * NT * LW); p.MIXb = c.take<bf16_t>((size_t)NT * D);
    p.H2b = c.take<bf16_t>((size_t)NT * H2S); p.LOGIT = c.take<float>((size_t)3 * NT * 128); p.RG = c.take<float>((size_t)NT * 2); p.RE = c.take<int>((size_t)NT * 2);
    p.SLOT_TOK = c.take<int>(NSLOT); p.SLOT_OF = c.take<int>((size_t)NT * 2 * 32); p.ACTb = c.take<bf16_t>((size_t)NSLOT * HID);
    p.LXRb = c.take<bf16_t>((size_t)NT * LW); p.LBX = c.take<float>((size_t)2 * NT * LW);
    p.AQb = c.take<bf16_t>((size_t)NT * AW); p.Kc = c.take<bf16_t>((size_t)NB * AKH * KK * HD); p.Vt = c.take<bf16_t>((size_t)NB * AKH * HD * KK);
#ifndef HOST_EMU
    p.Yb = c.take<bf16_t>((size_t)NSLOT * D);
    p.PROJb = c.take<bf16_t>((size_t)NT * NPJ); p.AB = c.take<float>((size_t)NT * 32);
    { const size_t ncp = (size_t)NB * GH * 2 * ((CTX + SEQ) / 64); p.GWN = c.take<bf16_t>(ncp * 4096); p.GQG = c.take<bf16_t>(ncp * 4096); p.GQK = c.take<bf16_t>(ncp * 4096); p.GKT = c.take<bf16_t>(ncp * 4096); p.GU = c.take<float>(ncp * 4096); p.GEL = c.take<float>(ncp * 32); }
    p.WinT = c.take<bf16_t>((size_t)DEPTH * NPJ * D); p.WoutT = c.take<bf16_t>((size_t)DEPTH * D * D);
    p.WrT = c.take<bf16_t>((size_t)DEPTH * 256 * H2S); p.WlT = c.take<bf16_t>((size_t)DEPTH * 4 * LW * LW); p.W13T = c.take<bf16_t>((size_t)DEPTH * NE * 2 * HID * D); p.W2T = c.take<bf16_t>((size_t)DEPTH * NE * D * HID);
#endif
    return c.off;
}
static inline void set_inputs(P& p, void* const* d_in, void* d_out) {
    const float** f = (const float**)&p.x;
    for (int i = 0; i < 31; ++i) f[i] = (const float*)d_in[i];
    p.out = (float*)d_out;
}

#ifndef HOST_EMU
#define XB_TMO      128
#define XB_XCNT(j)  (256  + 64 * (j))
#define XB_XSUB(j)  (1280 + 64 * (j))
#define XB_XGEN(j)  (2304 + 64 * (j))
#define XB_TOP      3328
#define XB_TOPGEN   3392
#define XCD_BAR_WORDS 3456
#define XB_SPIN_CAP (1u << 18)
__device__ __forceinline__ unsigned xb_ld(unsigned* p)              { return __hip_atomic_load(p, __ATOMIC_RELAXED, __HIP_MEMORY_SCOPE_AGENT); }
__device__ __forceinline__ unsigned xb_add(unsigned* p, unsigned v) { return __hip_atomic_fetch_add(p, v, __ATOMIC_RELAXED, __HIP_MEMORY_SCOPE_AGENT); }
__device__ __forceinline__ unsigned xb_xcc_id() { return (unsigned)__builtin_amdgcn_s_getreg((3 << 11) | 20) & 0xFu; }
#define XB_SPIN(cond, bar) do { unsigned _sp = 0; while (cond) { __builtin_amdgcn_s_sleep(1); \
    if ((++_sp & 255u) == 0u) { if (xb_ld(&(bar)[XB_TMO])) break; if (_sp > XB_SPIN_CAP) { atomicAdd(&(bar)[XB_TMO], 1u); break; } } } } while (0)
struct XcdBarrier { unsigned* bar; unsigned x; volatile LAS unsigned* st; };
__device__ __forceinline__ XcdBarrier xcd_barrier_post(unsigned* bar, volatile LAS unsigned* st) {
    XcdBarrier b; b.bar = bar; b.x = xb_xcc_id(); b.st = st;
    if (threadIdx.x == 0) (void)xb_add(&bar[XB_XCNT(b.x)], 1u);
    return b;
}
__device__ __forceinline__ void xcd_barrier_complete(unsigned* bar, unsigned x, unsigned& nloc, unsigned& nx) {
    const unsigned G = gridDim.x * gridDim.y * gridDim.z;
    unsigned sum, cnt, mine, sp = 0u;
    for (;;) {
        sum = 0u; cnt = 0u; mine = 0u;
#pragma unroll
        for (unsigned j = 0; j < 16; ++j) { const unsigned c = xb_ld(&bar[XB_XCNT(j)]); sum += c; cnt += (c > 0u) ? 1u : 0u; mine = (j == x) ? c : mine; }
        if (sum == G) break;
        __builtin_amdgcn_s_sleep(1);
        if ((++sp & 255u) == 0u) { if (xb_ld(&bar[XB_TMO])) break; if (sp > XB_SPIN_CAP) { atomicAdd(&bar[XB_TMO], 1u); break; } }
    }
    nloc = mine > 0u ? mine : 1u; nx = cnt > 0u ? cnt : 1u;
}
__device__ __forceinline__ void xcd_barrier(const XcdBarrier& b) {
    asm volatile("s_waitcnt vmcnt(0)" ::: "memory");
    __syncthreads();
    if (threadIdx.x == 0) {
        unsigned long long bq_ = (unsigned long long)b.bar; asm volatile("" : "+s"(bq_)); unsigned* bar = (unsigned*)(__attribute__((address_space(1))) unsigned*)bq_;
        __builtin_amdgcn_s_waitcnt(0);
        unsigned nloc = b.st[0], nx = b.st[1];
        if (nloc == 0u) { xcd_barrier_complete(bar, b.x, nloc, nx); b.st[0] = nloc; b.st[1] = nx; }
        const unsigned old = xb_add(&bar[XB_XSUB(b.x)], 1u);
        const unsigned gen = old / nloc;
        if (old + 1u == (gen + 1u) * nloc) {
            __builtin_amdgcn_fence(__ATOMIC_RELEASE, "agent");
            asm volatile("s_waitcnt vmcnt(0)" ::: "memory");
            const unsigned og = xb_add(&bar[XB_TOP], 1u);
            const unsigned tg = og / nx;
            if (og + 1u == (tg + 1u) * nx) xb_add(&bar[XB_TOPGEN], 1u);
            else XB_SPIN(xb_ld(&bar[XB_TOPGEN]) == tg, bar);
            __builtin_amdgcn_fence(__ATOMIC_ACQUIRE, "agent");
            xb_add(&bar[XB_XGEN(b.x)], 1u);
            asm volatile("s_waitcnt vmcnt(0)" ::: "memory");
        } else {
            XB_SPIN(xb_ld(&bar[XB_XGEN(b.x)]) == gen, bar);
            __builtin_amdgcn_fence(__ATOMIC_ACQUIRE, "agent");
            asm volatile("s_waitcnt vmcnt(0)" ::: "memory");
        }
    }
    __syncthreads();
}

constexpr int NTHREADS = 512;
constexpr int LDS_BYTES = 147456, LDS_MISC = 131072;
__global__ void __launch_bounds__(NTHREADS, 2) mega(P p, int ph_lo, int ph_hi) {
    extern __shared__ __attribute__((aligned(16))) unsigned char lds_raw[];
    LAS unsigned char* lds = (LAS unsigned char*)lds_raw;
    volatile LAS unsigned* misc = (volatile LAS unsigned*)(lds + LDS_MISC);
    if (threadIdx.x < 4) misc[threadIdx.x] = 0u;
    __syncthreads();
    if (threadIdx.x == 0) misc[2] = xb_xcc_id();
    (void)xcd_barrier_post(p.bar, misc);
    __syncthreads();
    const long gtid = 0, gsize = (long)gridDim.x * NTHREADS;
    auto bar = []() { LOADP; LAS unsigned char* l_ = (LAS unsigned char*)0; volatile LAS unsigned* m_ = (volatile LAS unsigned*)(l_ + LDS_MISC); XcdBarrier b; b.bar = p.bar; b.x = m_[2]; b.st = m_; xcd_barrier(b); };
#ifdef MK_MULTI
    run_phases<false>(p, ph_lo, ph_hi, gtid, gsize, lds, bar);
#else
    run_phases<true>(p, ph_lo, ph_hi, gtid, gsize, lds, bar);
#endif
}

extern "C" void kernel_launch(void* const* d_in, const int* in_sizes, int n_in, void* d_out, int out_size, void* d_ws, size_t ws_size, hipStream_t stream) {
    P p{}; set_inputs(p, d_in, d_out);
    if (carve(p, d_ws) > ws_size) { fprintf(stderr, "kernel_launch: workspace too small\n"); return; }
    static int grid = 0;
    if (!grid) {
        int dev = 0, cus = 0;
        (void)hipGetDevice(&dev); (void)hipDeviceGetAttribute(&cus, hipDeviceAttributeMultiprocessorCount, dev);
        (void)hipFuncSetAttribute((const void*)mega, hipFuncAttributeMaxDynamicSharedMemorySize, LDS_BYTES);
        grid = cus > 0 ? cus : 256;
    }
    (void)hipMemsetAsync(p.bar, 0, 4096 * sizeof(unsigned), stream);
#ifdef MK_MULTI
    for (int ph = 0; ph < TOTAL_PHASES; ++ph) mega<<<grid, NTHREADS, LDS_BYTES, stream>>>(p, ph, ph + 1);
#else
    mega<<<grid, NTHREADS, LDS_BYTES, stream>>>(p, 0, TOTAL_PHASES);
#endif
}
#endif
```

```cpp
#ifndef HOST_EMU
#include <hip/hip_runtime.h>
#endif
#include <cstdio>
#include <cstdint>
#include <cmath>


#ifndef CFG_D
#define CFG_D 1024
#define CFG_B 8
#define CFG_SEQ 2048
#define CFG_DEPTH 4
#define CFG_CTX 256
#define CFG_HID 512
#endif

#ifdef HOST_EMU
#define HIDE(x)
#define VZ 0
#define STORE_WT(ptr, v) (*(ptr) = (v))
#define DEV static inline
#define HD_INLINE static inline
static inline int atomicAdd(int* p, int v) { int o = *p; *p = o + v; return o; }
#else
#define HIDE(x) asm volatile("" : "+v"(x))
#define VZ ({ int z_ = 0; asm volatile("" : "+v"(z_)); z_; })
#define STORE_WT(ptr, v) __hip_atomic_store((ptr), (v), __ATOMIC_RELAXED, __HIP_MEMORY_SCOPE_AGENT)
#define DEV __device__ __forceinline__
#endif

constexpr int D = CFG_D, NB = CFG_B, SEQ = CFG_SEQ, DEPTH = CFG_DEPTH, CTX = CFG_CTX, HID = CFG_HID;
constexpr int HD = 64, GW = D / 4, GH = GW / HD, LW = D / 4, LBW = LW / 4, AW = D - GW - LW, AQH = AW / HD, AKH = 2, AG = AQH / AKH, KVW = AKH * HD;
constexpr int GP = 4 * GW + 4 * GH, LP = 2 * LW, AP = AW + 2 * KVW, PJ = GP + LP + AP;
constexpr int O_L = GP, O_A = GP + LP;
constexpr int NL = NB * SEQ, NC = NB * CTX, NT = NL + NC;
constexpr int NE = 64, NG = 8, EPG = 8, NLOG = NG + NE;
constexpr int MBLK = 256, NPJ = ((PJ + 255) / 256) * 256, PJS = NPJ  , NSLOT = NT * 2 + NE * MBLK, NBLK = NSLOT / MBLK;
constexpr int H2S = 3 * D;
constexpr int KK = SEQ + CTX;
constexpr float EPS = 1e-6f, QSCALE = 0.125f * 1.4426950408889634f;
static_assert(NSLOT % MBLK == 0, "slots");

typedef unsigned short bf16_t;
struct P {
    const float *x, *c, *ctx, *c_ctx, *w_ada, *b_ada, *norm1_g, *norm2_g, *w_in, *w_out, *gdn_conv_w, *gdn_a_log, *gdn_dt_bias, *gdn_norm_g;
    const float *lru_conv_w, *lru_conv_b, *lru_w_r, *lru_b_r, *lru_w_i, *lru_b_i, *lru_lambda, *attn_q_norm_g, *attn_k_norm_g;
    const float *moe_w_group, *moe_b_group, *moe_w_expert, *moe_b_expert, *moe_w1, *moe_w3, *moe_w2, *final_norm_g;
    float* out;
    unsigned* bar;
    float *AB, *LOGIT, *X, *MOD, *PART, *ROPE, *CARRY, *PROJ, *GQKV, *GG, *GB, *GO, *LXR, *LA, *LBX, *LH, *AQ, *AK, *RG, *Y;
    int *RE, *CNT, *OFF, *BLKE, *SLOT_TOK, *SLOT_OF;
    bf16_t *Yb, *HNb, *MIXb, *H2b, *ACTb, *WinT, *WoutT, *W13T, *W2T, *WrT, *WlT, *LXRb, *PROJb, *AQb, *Kc, *Vt, *GWN, *GQG, *GQK, *GKT;
    float *GU, *GEL;
};

#ifdef HOST_EMU
DEV float fexp(float x) { return expf(x); }
DEV float flog(float x) { return logf(x); }
DEV float frcp(float x) { return 1.0f / x; }
DEV float frsq(float x) { return 1.0f / sqrtf(x); }
#else
DEV float fexp(float x) { return __expf(x); }
DEV float flog(float x) { return __logf(x); }
DEV float frcp(float x) { return __builtin_amdgcn_rcpf(x); }
DEV float frsq(float x) { return __builtin_amdgcn_rsqf(x); }
#endif
DEV float siluf(float x) { return x * frcp(1.f + fexp(-x)); }
DEV float sigmoidf(float x) { return frcp(1.f + fexp(-x)); }
DEV float softplusf(float x) { if (x > 15.f) return x; const float e = fexp(x); return e < 1e-3f ? e * (1.f - 0.5f * e) : flog(1.f + e); }
DEV float neg_expm1f(float y) { return fabsf(y) < 0.01f ? -y * (1.f + y * (0.5f + y * 0.16666667f)) : 1.f - fexp(y); }
DEV float gelu_tanhf(float x) { const float u = 0.7978845608028654f * (x + 0.044715f * x * x * x); return x * frcp(1.f + fexp(-2.f * u)); }
DEV bf16_t f2bf(float f) { unsigned u = __builtin_bit_cast(unsigned, f); return (bf16_t)((u + 0x7fffu + ((u >> 16) & 1u)) >> 16); }
DEV float bf2f(bf16_t h) { return __builtin_bit_cast(float, (unsigned)h << 16); }
DEV int tok_modrow(int n) { return n < NL ? n / SEQ : NB; }
DEV void tok_seg(int n, int& s0, int& len) { if (n < NL) { s0 = (n / SEQ) * SEQ; len = SEQ; } else { s0 = NL + ((n - NL) / CTX) * CTX; len = CTX; } }

DEV void ph_mod(const P& p, long gtid, long gsize) {
    for (long it = gtid; it < (long)DEPTH * 6 * D; it += gsize) {
        const int l = (int)(it / (6 * D)), j = (int)(it % (6 * D));
        float acc[NB + 1];
#pragma unroll
        for (int r = 0; r <= NB; ++r) acc[r] = 0.f;
        const float* w = p.w_ada + (size_t)l * D * 6 * D + j;
        for (int k = 0; k < D; ++k) {
            const float wv = w[(size_t)k * 6 * D];
#pragma unroll
            for (int r = 0; r <= NB; ++r) { const float cv = r < NB ? p.c[r * D + k] : p.c_ctx[k]; acc[r] += siluf(cv) * wv; }
        }
        const float bv = p.b_ada[l * 6 * D + j];
#pragma unroll
        for (int r = 0; r <= NB; ++r) p.MOD[((size_t)l * (NB + 1) + r) * 6 * D + j] = acc[r] + bv;
    }
}
DEV void ph_rope(const P& p, long gtid, long gsize) {
    for (long it = gtid; it < (long)SEQ * 16; it += gsize) {
        const int t = (int)(it / 16), i = (int)(it % 16);
        const float inv = powf(10000.0f, -(float)(2 * i) / 32.0f), ar = (float)(t / 64) * inv, ac = (float)(t % 64) * inv;
        float* rt = p.ROPE + (size_t)t * 64;
        rt[i] = cosf(ar); rt[16 + i] = sinf(ar); rt[32 + i] = cosf(ac); rt[48 + i] = sinf(ac);
    }
}
DEV void ph_init(const P& p, long gtid, long gsize) {
    for (long it = gtid; it < (long)NT * D; it += gsize) p.X[it] = it < (long)NL * D ? p.x[it] : p.ctx[it - (long)NL * D];
}
DEV void norm_row(const P& p, int l, int n, int which, bf16_t* dst) {
    const float* xr = p.X + (size_t)n * D;
    float ss = 0.f;
    for (int k = 0; k < D; ++k) ss += xr[k] * xr[k];
    const float rs = frsq(ss / D + EPS);
    const float* g = (which ? p.norm2_g : p.norm1_g) + l * D;
    const float* md = p.MOD + ((size_t)l * (NB + 1) + tok_modrow(n)) * 6 * D + (which ? 3 * D : 0);
    for (int k = 0; k < D; ++k) dst[k] = f2bf(xr[k] * rs * g[k] * (1.f + md[D + k]) + md[k]);
}
DEV void ph_norm1_aux(const P& p, long gtid, long gsize);
DEV void ph_norm1(const P& p, int l, long gtid, long gsize) {
    for (long it = gtid; it < NT; it += gsize) norm_row(p, l, (int)it, 0, p.HNb + (size_t)it * D);
    ph_norm1_aux(p, gtid, gsize);
}
DEV void ph_norm1_aux(const P& p, long gtid, long gsize) {
    for (long it = gtid; it < NE; it += gsize) p.CNT[it] = 0;
}

template <bool DUAL, class RowA, class Epi>
DEV void gemm_naive(int Mtiles, int N, int K, RowA rowA, const float* B, const float* B2, int ldb, Epi epi, long gtid, long gsize) {
    const int nt = N / 4;
    for (long it = gtid; it < (long)Mtiles * nt; it += gsize) {
        const int mt = (int)(it / nt), n0 = (int)(it % nt) * 4;
        const bf16_t* a[4]; const float* Bb = B; const float* Bb2 = B2; bool any = false;
#pragma unroll
        for (int i = 0; i < 4; ++i) { a[i] = rowA(mt * 4 + i, Bb, Bb2); any |= a[i] != nullptr; }
        if (!any) continue;
        float acc[4][4], acc2[4][4];
#pragma unroll
        for (int i = 0; i < 4; ++i)
#pragma unroll
            for (int j = 0; j < 4; ++j) { acc[i][j] = 0.f; acc2[i][j] = 0.f; }
        for (int k = 0; k < K; ++k) {
            const float* bp = Bb + (size_t)k * ldb + n0;
            const float b0 = bp[0], b1 = bp[1], b2 = bp[2], b3 = bp[3];
            float c0 = 0, c1 = 0, c2 = 0, c3 = 0;
            if (DUAL) { const float* bq = Bb2 + (size_t)k * ldb + n0; c0 = bq[0]; c1 = bq[1]; c2 = bq[2]; c3 = bq[3]; }
#pragma unroll
            for (int i = 0; i < 4; ++i) {
                const float av = a[i] ? bf2f(a[i][k]) : 0.f;
                acc[i][0] += av * b0; acc[i][1] += av * b1; acc[i][2] += av * b2; acc[i][3] += av * b3;
                if (DUAL) { acc2[i][0] += av * c0; acc2[i][1] += av * c1; acc2[i][2] += av * c2; acc2[i][3] += av * c3; }
            }
        }
#pragma unroll
        for (int i = 0; i < 4; ++i) if (a[i]) epi(mt * 4 + i, n0, acc[i], acc2[i]);
    }
}

DEV void ph_inproj(const P& p, int l, long gtid, long gsize) {
    const float* W = p.w_in + (size_t)l * D * PJ;
    gemm_naive<false>(NT / 4, PJ, D,
        [&](int m, const float*&, const float*&) { return p.HNb + (size_t)m * D; }, W, nullptr, PJ,
        [&](int m, int n0, const float* acc, const float*) { float* o = p.PROJ + (size_t)m * PJS + n0; o[0] = acc[0]; o[1] = acc[1]; o[2] = acc[2]; o[3] = acc[3]; },
        gtid, gsize);
}

DEV float conv4(const P& p, int n, int s0, int len, const float* w, int wstride, int c, int col) {
    float acc = 0.f;
#pragma unroll
    for (int j = 0; j < 4; ++j) { const int m = n + j - 1; if (m >= s0 && m < s0 + len) acc += w[j * wstride + c] * p.PROJ[(size_t)m * PJS + col]; }
    return acc;
}
DEV void ph_prep(const P& p, int l, long gtid, long gsize) {
    for (long it = gtid; it < (long)NT * 3 * GH; it += gsize) {
        const int n = (int)(it / (3 * GH)), wh = (int)(it % (3 * GH)), which = wh / GH, h = wh % GH;
        int s0, len; tok_seg(n, s0, len);
        const float* w = p.gdn_conv_w + (size_t)l * 4 * 3 * GW;
        float* o = p.GQKV + (size_t)n * 3 * GW + which * GW + h * HD;
        float ss = 0.f;
        for (int d = 0; d < HD; ++d) { const int c = which * GW + h * HD + d; const float v = siluf(conv4(p, n, s0, len, w, 3 * GW, c, c)); ss += v * v; o[d] = v; }
        if (which < 2) {
            float sc = frsq(ss + EPS); if (which == 0) sc *= 0.125f;
            for (int d = 0; d < HD; ++d) o[d] *= sc;
        }
    }
    for (long it = gtid; it < (long)NT * 2 * GH; it += gsize) {
        const int n = (int)(it / (2 * GH)), dh = (int)(it % (2 * GH));
        const float al = p.PROJ[(size_t)n * PJS + 4 * GW + dh], be = p.PROJ[(size_t)n * PJS + 4 * GW + 2 * GH + dh];
        p.GG[it] = -fexp(p.gdn_a_log[l * 2 * GH + dh]) * softplusf(al + p.gdn_dt_bias[l * 2 * GH + dh]);
        p.GB[it] = sigmoidf(be);
    }
    for (long it = gtid; it < (long)NT * LW; it += gsize) {
        const int n = (int)(it / LW), c = (int)(it % LW);
        int s0, len; tok_seg(n, s0, len);
        const float xv = conv4(p, n, s0, len, p.lru_conv_w + (size_t)l * 4 * LW, LW, c, O_L + c) + p.lru_conv_b[l * LW + c];
        p.LXR[it] = xv; p.LXRb[it] = f2bf(xv);
    }
    for (long it = gtid; it < (long)NT * (AQH + AKH); it += gsize) {
        const int n = (int)(it / (AQH + AKH)), hh = (int)(it % (AQH + AKH));
        const bool isq = hh < AQH;
        const float* src = p.PROJ + (size_t)n * PJS + O_A + (isq ? hh * HD : AW + (hh - AQH) * HD);
        const float* g = (isq ? p.attn_q_norm_g : p.attn_k_norm_g) + l * HD;
        float ss = 0.f;
        for (int d = 0; d < HD; ++d) ss += src[d] * src[d];
        const float rs = frsq(ss / HD + EPS);
        float* o = isq ? p.AQ + (size_t)n * AW + hh * HD : p.AK + (size_t)n * KVW + (hh - AQH) * HD;
        if (n < NL) {
            const int t = n % SEQ;
            const float* rt = p.ROPE + (size_t)t * 64;
            for (int i = 0; i < 16; ++i) {
                const float cr = rt[i], sr = rt[16 + i], cc = rt[32 + i], sc = rt[48 + i];
                const float x1 = src[i] * rs * g[i], x2 = src[16 + i] * rs * g[16 + i], y1 = src[32 + i] * rs * g[32 + i], y2 = src[48 + i] * rs * g[48 + i];
                o[i] = x1 * cr - x2 * sr; o[16 + i] = x1 * sr + x2 * cr;
                o[32 + i] = y1 * cc - y2 * sc; o[48 + i] = y1 * sc + y2 * cc;
            }
        } else {
            for (int d = 0; d < HD; ++d) o[d] = src[d] * rs * g[d];
        }
        const int b = n < NL ? n / SEQ : (n - NL) / CTX, kk = n < NL ? n % SEQ : SEQ + (n - NL) % CTX;
        if (isq) { bf16_t* qb = p.AQb + (size_t)n * AW + hh * HD; for (int d = 0; d < HD; ++d) qb[d] = f2bf(o[d] * QSCALE); }
        else {
            const int kvh = hh - AQH;
            bf16_t* kb = p.Kc + ((size_t)(b * AKH + kvh) * KK + kk) * HD; for (int d = 0; d < HD; ++d) kb[d] = f2bf(o[d]);
        }
    }
    for (long it = gtid; it < (long)NB * AKH * (KK / 64) * HD; it += gsize) {
        const int d = (int)(it % HD), kb = (int)(it / HD) % (KK / 64), kvh = (int)(it / (HD * (KK / 64))) % AKH, b = (int)(it / (HD * (KK / 64) * AKH));
        const int n0 = kb * 64 < SEQ ? b * SEQ + kb * 64 : NL + b * CTX + (kb * 64 - SEQ);
        const float* vsrc = p.PROJ + (size_t)n0 * PJS + O_A + AW + KVW + kvh * HD + d;
        bf16_t* vb = p.Vt + ((size_t)(b * AKH + kvh) * HD + d) * KK + kb * 64;
        for (int i = 0; i < 64; i += 2) { const unsigned w = (unsigned)f2bf(vsrc[(size_t)i * PJS]) | ((unsigned)f2bf(vsrc[(size_t)(i + 1) * PJS]) << 16); *(unsigned*)(vb + i) = w; }
    }
}
constexpr int NCH = (CTX + SEQ) / 64, NCC = CTX / 64;
DEV int chunk_tok(int b, int dir, int ci, int i) {
    if (ci < NCC) { const int pos = ci * 64 + i; return NL + b * CTX + (dir ? CTX - 1 - pos : pos); }
    const int pos = (ci - NCC) * 64 + i; return b * SEQ + (dir ? SEQ - 1 - pos : pos);
}
DEV int tok_chunk(int n, int dir) {
    if (n < NL) { const int t = n % SEQ; return NCC + (dir ? SEQ - 1 - t : t) / 64; }
    const int sidx = (n - NL) % CTX; return (dir ? CTX - 1 - sidx : sidx) / 64;
}
DEV void ph_lru_local(const P& p, int l, long gtid, long gsize) {
    for (long it = gtid; it < (long)NB * 2 * NCH * LW; it += gsize) {
        const int c = (int)(it % LW), ci = (int)(it / LW) % NCH, dir = (int)(it / (LW * NCH)) % 2, b = (int)(it / (LW * NCH * 2)), blk = c / LBW, e = c % LBW;
        const float* wr = p.lru_w_r + ((size_t)(l * 2 + dir) * 4 + blk) * LBW * LBW + e;
        const float* wi = p.lru_w_i + ((size_t)(l * 2 + dir) * 4 + blk) * LBW * LBW + e;
        const float br = p.lru_b_r[(l * 2 + dir) * LW + c], bi = p.lru_b_i[(l * 2 + dir) * LW + c], sp = softplusf(-p.lru_lambda[(l * 2 + dir) * LW + c]);
        float h = 0.f, A = 1.f;
        for (int i = 0; i < 64; ++i) {
            const int n = chunk_tok(b, dir, ci, i);
            const float* xr = p.LXR + (size_t)n * LW + blk * LBW;
            float ar = 0.f, ai = 0.f;
            for (int d = 0; d < LBW; ++d) { const float xv = xr[d]; ar += xv * wr[d * LBW]; ai += xv * wi[d * LBW]; }
            const float r = sigmoidf(ar + br), ig = sigmoidf(ai + bi), log_a = -8.0f * r * sp, a = fexp(log_a);
            const float bx = sqrtf(neg_expm1f(2.0f * log_a)) * (ig * p.LXR[(size_t)n * LW + c]);
            h = a * h + bx; A *= a;
            const size_t ix = ((size_t)dir * NT + n) * LW + c;
            p.LH[ix] = h; p.LA[ix] = A;
        }
    }
}
#ifndef HOST_EMU
__device__ __forceinline__ void ph_lru_carry_w(const P& p, long gtid, long gsize) {
    const bf16_t* LHb = (const bf16_t*)p.LH; const bf16_t* LAb = LHb + (size_t)2 * NT * LW;
    for (long it = gtid; it < (long)NB * 2 * LW; it += gsize) {
        const int c = (int)(it % LW), dir = (int)(it / LW) % 2, b = (int)(it / (2 * LW));
        float H = 0.f;
        for (int ci = 0; ci < NCH; ++ci) {
            p.CARRY[((size_t)(b * 2 + dir) * NCH + ci) * LW + c] = H;
            const size_t ix = ((size_t)dir * NT + chunk_tok(b, dir, ci, 63)) * LW + c;
            H = bf2f(LAb[ix]) * H + bf2f(LHb[ix]);
        }
    }
}
#endif
DEV void ph_lru_carry(const P& p, long gtid, long gsize) {
    for (long it = gtid; it < (long)NB * 2 * LW; it += gsize) {
        const int c = (int)(it % LW), dir = (int)(it / LW) % 2, b = (int)(it / (2 * LW));
        float H = 0.f;
        for (int ci = 0; ci < NCH; ++ci) {
            p.CARRY[((size_t)(b * 2 + dir) * NCH + ci) * LW + c] = H;
            const size_t ix = ((size_t)dir * NT + chunk_tok(b, dir, ci, 63)) * LW + c;
            H = p.LA[ix] * H + p.LH[ix];
        }
    }
}
DEV void ph_gdn_naive(const P& p, int l, long gtid, long gsize) {
    for (long it = gtid; it < (long)NB * GH * 2 * HD; it += gsize) {
        const int dv = (int)(it % HD), dir = (int)(it / HD) % 2, h = (int)(it / (2 * HD)) % GH, b = (int)(it / (2 * HD * GH));
        float S[HD];
#pragma unroll
        for (int d = 0; d < HD; ++d) S[d] = 0.f;
        for (int ph = 0; ph < 2; ++ph) {
            const int len = ph == 0 ? CTX : SEQ, base = ph == 0 ? NL + b * CTX : b * SEQ;
            for (int i = 0; i < len; ++i) {
                const int n = base + (dir == 0 ? i : len - 1 - i);
                const float a = fexp(p.GG[(size_t)n * 2 * GH + dir * GH + h]), bt = p.GB[(size_t)n * 2 * GH + dir * GH + h];
                const float* q = p.GQKV + (size_t)n * 3 * GW + h * HD; const float* k = q + GW; const float v = q[2 * GW + dv];
                float ks = 0.f;
#pragma unroll
                for (int d = 0; d < HD; ++d) { S[d] *= a; ks += k[d] * S[d]; }
                const float cc = bt * (v - ks); float o = 0.f;
#pragma unroll
                for (int d = 0; d < HD; ++d) { S[d] += k[d] * cc; o += q[d] * S[d]; }
                p.GO[((size_t)dir * NT + n) * GW + h * HD + dv] = o;
            }
        }
    }
}
DEV void ph_attn(const P& p, int l, int ntok, long gtid, long gsize) {
    for (long it = gtid; it < (long)ntok * AQH; it += gsize) {
        const int n = (int)(it / AQH), hq = (int)(it % AQH), kvh = hq / AG;
        const float* qp = p.AQ + (size_t)n * AW + hq * HD;
        float q[HD], o[HD];
#pragma unroll
        for (int d = 0; d < HD; ++d) { q[d] = qp[d] * 0.125f; o[d] = 0.f; }
        float m = -1e30f, lsum = 0.f;
        const int b = n < NL ? n / SEQ : (n - NL) / CTX;
        for (int ph = (n < NL ? 0 : 1); ph < 2; ++ph) {
            const int len = ph == 0 ? SEQ : CTX, base = ph == 0 ? b * SEQ : NL + b * CTX;
            for (int j = 0; j < len; ++j) {
                const float* kp = p.AK + (size_t)(base + j) * KVW + kvh * HD;
                const float* vp = p.PROJ + (size_t)(base + j) * PJS + O_A + AW + KVW + kvh * HD;
                float s = 0.f;
#pragma unroll
                for (int d = 0; d < HD; ++d) s += q[d] * kp[d];
                const float mn = fmaxf(m, s), corr = fexp(m - mn), pe = fexp(s - mn);
                lsum = lsum * corr + pe;
#pragma unroll
                for (int d = 0; d < HD; ++d) o[d] = o[d] * corr + pe * vp[d];
                m = mn;
            }
        }
        const float inv = 1.f / lsum; bf16_t* op = p.MIXb + (size_t)n * D + GW + LW + hq * HD;
#pragma unroll
        for (int d = 0; d < HD; ++d) op[d] = f2bf(o[d] * inv);
    }
}
DEV void ph_readout(const P& p, int l, int ntok, long gtid, long gsize) {
    for (long it = gtid; it < (long)ntok * GH; it += gsize) {
        const int n = (int)(it / GH), h = (int)(it % GH);
        const float* o0 = p.GO + (size_t)n * GW + h * HD; const float* o1 = p.GO + ((size_t)NT + n) * GW + h * HD;
        const float* gate = p.PROJ + (size_t)n * PJS + 3 * GW + h * HD; const float* g = p.gdn_norm_g + l * HD;
        float v[HD]; float ss = 0.f;
#pragma unroll
        for (int d = 0; d < HD; ++d) { v[d] = o0[d] + o1[d]; ss += v[d] * v[d]; }
        const float rs = frsq(ss / HD + EPS); bf16_t* op = p.MIXb + (size_t)n * D + h * HD;
#pragma unroll
        for (int d = 0; d < HD; ++d) op[d] = f2bf(v[d] * rs * g[d] * siluf(gate[d]));
    }
    for (long it = gtid; it < (long)ntok * LW; it += gsize) {
        const int n = (int)(it / LW), c = (int)(it % LW);
        const int bb = n < NL ? n / SEQ : (n - NL) / CTX;
        float hs = 0.f;
#pragma unroll
        for (int d = 0; d < 2; ++d) { const size_t ix = ((size_t)d * NT + n) * LW + c; hs += p.LH[ix] + p.LA[ix] * p.CARRY[((size_t)(bb * 2 + d) * NCH + tok_chunk(n, d)) * LW + c]; }
        p.MIXb[(size_t)n * D + GW + c] = f2bf(hs * gelu_tanhf(p.PROJ[(size_t)n * PJS + O_L + LW + c]));
    }
}
DEV void ph_outproj(const P& p, int l, int ntok, long gtid, long gsize) {
    const float* W = p.w_out + (size_t)l * D * D;
    gemm_naive<false>(ntok / 4, D, D,
        [&](int m, const float*&, const float*&) { return p.MIXb + (size_t)m * D; }, W, nullptr, D,
        [&](int m, int n0, const float* acc, const float*) {
            const float* g1 = p.MOD + ((size_t)l * (NB + 1) + tok_modrow(m)) * 6 * D + 2 * D + n0; float* o = p.X + (size_t)m * D + n0;
            o[0] += g1[0] * acc[0]; o[1] += g1[1] * acc[1]; o[2] += g1[2] * acc[2]; o[3] += g1[3] * acc[3]; },
        gtid, gsize);
}
DEV void ph_route(const P& p, int l, int ntok, long gtid, long gsize) {
    for (long it = gtid; it < ntok; it += gsize) {
        const int n = (int)it; bf16_t* h = p.H2b + (size_t)n * H2S;
        norm_row(p, l, n, 1, h);
        float lg[NLOG];
#pragma unroll
        for (int j = 0; j < NG; ++j) lg[j] = p.moe_b_group[l * NG + j];
#pragma unroll
        for (int j = 0; j < NE; ++j) lg[NG + j] = p.moe_b_expert[l * NE + j];
        const float* wg = p.moe_w_group + (size_t)l * D * NG; const float* we = p.moe_w_expert + (size_t)l * D * NE;
        for (int k = 0; k < D; ++k) {
            const float hv = bf2f(h[k]);
#pragma unroll
            for (int j = 0; j < NG; ++j) lg[j] += hv * wg[k * NG + j];
#pragma unroll
            for (int j = 0; j < NE; ++j) lg[NG + j] += hv * we[k * NE + j];
        }
        int gi = 0; float gm = lg[0];
#pragma unroll
        for (int j = 1; j < NG; ++j) if (lg[j] > gm) { gm = lg[j]; gi = j; }
        float gs = 0.f;
#pragma unroll
        for (int j = 0; j < NG; ++j) gs += fexp(lg[j] - gm);
        const float pg = 1.f / gs;
        float e1 = -1e30f, e2 = -1e30f; int i1 = 0, i2 = 0;
#pragma unroll
        for (int g = 0; g < NG; ++g) if (g == gi) {
#pragma unroll
            for (int j = 0; j < EPG; ++j) { const float v = lg[NG + g * EPG + j]; if (v > e1) { e2 = e1; i2 = i1; e1 = v; i1 = j; } else if (v > e2) { e2 = v; i2 = j; } }
        }
        const float w2 = fexp(e2 - e1), inv = 1.f / (1.f + w2);
        const int ex0 = gi * EPG + i1, ex1 = gi * EPG + i2;
        p.RE[n * 2] = ex0; p.RE[n * 2 + 1] = ex1; p.RG[n * 2] = pg * inv; p.RG[n * 2 + 1] = pg * w2 * inv;
        atomicAdd(&p.CNT[ex0], 1); atomicAdd(&p.CNT[ex1], 1);
    }
}
DEV void ph_offsets(const P& p, long gtid, long gsize) {
    if (gtid == 0) {
        int off = 0;
        for (int e = 0; e < NE; ++e) { p.OFF[e * 32] = off; const int pad = (p.CNT[e] + MBLK - 1) / MBLK * MBLK; for (int b = off / MBLK; b < (off + pad) / MBLK; ++b) p.BLKE[b * 32] = e; off += pad; }
        p.OFF[NE * 32] = off;
        for (int b = off / MBLK; b < NBLK; ++b) p.BLKE[b * 32] = -1;
    }
}
DEV void ph_slots(const P& p, int ntok, long gtid, long gsize) {
    for (long e = gtid; e < NE; e += gsize) {
        int s = p.OFF[e * 32];
        for (int i = 0; i < ntok * 2; ++i) if (p.RE[i] == (int)e) { p.SLOT_TOK[s] = i >> 1; p.SLOT_OF[(size_t)i * 32] = s; ++s; }
        for (; s < p.OFF[(e + 1) * 32]; ++s) p.SLOT_TOK[s] = -1;
    }
}
DEV void ph_moe1(const P& p, int l, long gtid, long gsize) {
    gemm_naive<true>(NSLOT / 4, HID, D,
        [&](int m, const float*& B, const float*& B2) -> const bf16_t* {
            const int e = p.BLKE[(m / MBLK) * 32]; if (e < 0) return nullptr;
            B = p.moe_w1 + ((size_t)l * NE + e) * D * HID; B2 = p.moe_w3 + ((size_t)l * NE + e) * D * HID;
            const int t = p.SLOT_TOK[m]; return t < 0 ? nullptr : p.H2b + (size_t)t * H2S; },
        nullptr, nullptr, HID,
        [&](int m, int n0, const float* a1, const float* a3) { bf16_t* o = p.ACTb + (size_t)m * HID + n0;
#pragma unroll
            for (int j = 0; j < 4; ++j) o[j] = f2bf(siluf(a1[j]) * a3[j]); },
        gtid, gsize);
}
DEV void ph_moe2(const P& p, int l, long gtid, long gsize) {
    gemm_naive<false>(NSLOT / 4, D, HID,
        [&](int m, const float*& B, const float*&) -> const bf16_t* {
            const int e = p.BLKE[(m / MBLK) * 32]; if (e < 0) return nullptr;
            B = p.moe_w2 + ((size_t)l * NE + e) * HID * D;
            return p.SLOT_TOK[m] < 0 ? nullptr : p.ACTb + (size_t)m * HID; },
        nullptr, nullptr, D,
        [&](int m, int n0, const float* acc, const float*) { float* o = p.Y + (size_t)m * D + n0; o[0] = acc[0]; o[1] = acc[1]; o[2] = acc[2]; o[3] = acc[3]; },
        gtid, gsize);
}
DEV void ph_combine(const P& p, int l, int ntok, long gtid, long gsize) {
    for (long it = gtid; it < (long)ntok * D; it += gsize) {
        const int n = (int)(it / D), j = (int)(it % D);
        const float g2 = p.MOD[((size_t)l * (NB + 1) + tok_modrow(n)) * 6 * D + 5 * D + j];
        const float y = p.RG[n * 2] * p.Y[(size_t)p.SLOT_OF[(size_t)n * 64] * D + j] + p.RG[n * 2 + 1] * p.Y[(size_t)p.SLOT_OF[(size_t)n * 64 + 32] * D + j];
        p.X[it] += g2 * y;
    }
}
DEV void ph_final(const P& p, long gtid, long gsize) {
    for (long it = gtid; it < NL; it += gsize) {
        const float* xr = p.X + (size_t)it * D; float ss = 0.f;
        for (int k = 0; k < D; ++k) ss += xr[k] * xr[k];
        const float rs = frsq(ss / D + EPS);
        for (int k = 0; k < D; ++k) p.out[(size_t)it * D + k] = xr[k] * rs * p.final_norm_g[k];
    }
}


#ifndef HOST_EMU
#define LAS __attribute__((address_space(3)))
namespace pg8 {
typedef short bf16x8 __attribute__((ext_vector_type(8)));
typedef float f32x4 __attribute__((ext_vector_type(4)));
typedef unsigned u32x4 __attribute__((ext_vector_type(4)));
typedef unsigned u32x2 __attribute__((ext_vector_type(2)));
constexpr int BM = 256, BK = 64, HALF = 128, HTB = HALF * BK * 2, STAGE_BYTES = 8 * HTB, NXCD = 8, WGM = 4;
__device__ __forceinline__ int lds_byte(int r, int c) { const int st = (r >> 4) * 2 + (c >> 5), rr = r & 15, cc = c & 31, ob = rr * 64 + cc * 2; return st * 1024 + (ob ^ (((ob >> 9) & 1) << 5)); }
__device__ __forceinline__ void stage_rc(int b, int& R, int& C) { const int st = b / 1024, sb = b % 1024, swz = sb ^ (((sb >> 9) & 1) << 5); R = (st >> 1) * 16 + swz / 64; C = (st & 1) * 32 + (swz % 64) / 2; }
__device__ __forceinline__ int perm32(int rho) { const int n = rho >> 4, i = rho & 15; return 8 * (i >> 2) + 4 * n + (i & 3); }
typedef float f32x2c __attribute__((ext_vector_type(2))); typedef __bf16 bf16x2c __attribute__((ext_vector_type(2)));
__device__ __forceinline__ unsigned cvt_pk_bf16(float lo, float hi) { const f32x2c v = {lo, hi}; return __builtin_bit_cast(unsigned, __builtin_convertvector(v, bf16x2c)); }

struct Unit { int row0, col0; const char* B; const int* rows; int aoff; };

struct DenseSched {
    int nM, nN, nwg, G, c; const char* Bt; int K;
    __device__ void init(int M, int N, int K_, const void* Bt_, int G_, int c_) { nM = M / BM; nN = N / BM; nwg = nM * nN; G = G_; c = c_; Bt = (const char*)Bt_; K = K_; }
    __device__ bool next(int i, Unit& u) const {
        const long L = (long)i * G + c; if (L >= nwg) return false;
        int wgid = (int)L; { const int q = nwg / NXCD, r = nwg % NXCD, xcd = wgid % NXCD, off = wgid / NXCD; wgid = (xcd < r ? xcd * (q + 1) : r * (q + 1) + (xcd - r) * q) + off; }
        const int nig = WGM * nN, gid = wgid / nig, fm = gid * WGM, gsz = (nM - fm) < WGM ? (nM - fm) : WGM;
        const int pm = fm + ((wgid % nig) % gsz), pn = (wgid % nig) / gsz;
        u.row0 = pm * BM; u.col0 = pn * BM; u.B = Bt + (size_t)pn * BM * K * 2; u.rows = nullptr; u.aoff = 0; return true;
    }
};
struct MoeSched {
    int nunits, G, c; const char* W; size_t estride; int K; const int* blke; const int* rows;
    __device__ bool next(int i, Unit& u) const {
        const long L = (long)i * G + c; if (L >= nunits) return false;
        const int pm = (int)(L >> 2), pn = (int)(L & 3), e = __builtin_amdgcn_readfirstlane(blke[pm * 32 + VZ]);
        u.row0 = pm * BM; u.col0 = pn * BM; u.B = W + (size_t)e * estride + (size_t)pn * BM * K * 2; u.rows = rows ? rows + pm * BM : nullptr; u.aoff = 0; return true;
    }
};

template <class Epi, class Sched>
__device__ __forceinline__ void gemm_phase(LAS unsigned char* lds, const void* gA_, const int K, const int lda, const int ldb, const Sched& S, const Epi& E) {
    const char* gA = (const char*)gA_;
    int tid = threadIdx.x; asm volatile("" : "+v"(tid));
    const int wid = __builtin_amdgcn_readfirstlane(tid >> 6), lane = tid & 63, wr = wid >> 2, wc = wid & 3, fr = lane & 15, fq = lane >> 4;
    const int nt = K / BK;
    unsigned voffB[2];
#pragma unroll
    for (int i = 0; i < 2; ++i) { int R, C; stage_rc(tid * 16 + i * 8192, R, C); const int Rb = (R & ~31) + perm32(R & 31); voffB[i] = (unsigned)(Rb * ldb + C) * 2u; }
    LAS u32x4* park = (LAS u32x4*)(lds + 131072 + 64) + tid;
    const size_t kstep = (size_t)(BK * 2);
    const size_t hstepA = 0; (void)hstepA; const size_t hstep = (size_t)HALF * ldb * 2;
    const unsigned ldsw = (unsigned)wid * 1024u;
    const int aoff = lds_byte(wr * 64 + fr, fq * 8), boff = lds_byte(wc * 32 + fr, fq * 8);
#define PG8_SA(b, h) (((b) * 2 + (h)) * HTB)
#define PG8_SB(b, h) ((4 + (b) * 2 + (h)) * HTB)
#define PG8_STAGE_B(bufoff, gbase) do { _Pragma("unroll") for (int _i = 0; _i < 2; ++_i) \
        __builtin_amdgcn_global_load_lds((const unsigned*)((const char*)(gbase) + voffB[_i]), (LAS unsigned*)(lds + (bufoff) + ldsw + _i * 8192), 16, 0, 0); } while (0)
#define PG8_STAGE_A(bufoff, vo, kb) do { _Pragma("unroll") for (int _i = 0; _i < 2; ++_i) \
        __builtin_amdgcn_global_load_lds((const unsigned*)(gA + (kb) + (vo(_i))), (LAS unsigned*)(lds + (bufoff) + ldsw + _i * 8192), 16, 0, 0); } while (0)
#define VC0(i) vc[0][i]
#define VC1(i) vc[1][i]
#define V20(i) vc[0][i]
#define V21(i) vc[1][i]
#define PG8_LDA(dst, b, h) do { _Pragma("unroll") for (int m = 0; m < 4; ++m) _Pragma("unroll") for (int k = 0; k < 2; ++k) dst[m][k] = *(const LAS bf16x8*)(lds + PG8_SA(b, h) + aoff + m * 2048 + k * 1024); } while (0)
#define PG8_LDB(dst, b, h) do { _Pragma("unroll") for (int n = 0; n < 2; ++n) _Pragma("unroll") for (int k = 0; k < 2; ++k) dst[n][k] = *(const LAS bf16x8*)(lds + PG8_SB(b, h) + boff + n * 2048 + k * 1024); } while (0)
#define PG8_MMA(ai, bj, At, Bt) do { __builtin_amdgcn_s_setprio(1); _Pragma("unroll") for (int m = 0; m < 4; ++m) _Pragma("unroll") for (int n = 0; n < 2; ++n) _Pragma("unroll") for (int k = 0; k < 2; ++k) \
        acc[ai][bj][m][n] = __builtin_amdgcn_mfma_f32_16x16x32_bf16(Bt[n][k], At[m][k], acc[ai][bj][m][n], 0, 0, 0); __builtin_amdgcn_s_setprio(0); } while (0)
#define PG8_WAIT_V(n) asm volatile("s_waitcnt vmcnt(" #n ")" ::: "memory")
#define PG8_WAIT_L(n) asm volatile("s_waitcnt lgkmcnt(" #n ")" ::: "memory")
#define PG8_BAR __builtin_amdgcn_s_barrier()
#define PG8_SCHED __builtin_amdgcn_sched_barrier(0)
#define PG8_MKVO(u, vo) do { _Pragma("unroll") for (int _h = 0; _h < 2; ++_h) _Pragma("unroll") for (int _i = 0; _i < 2; ++_i) { int _R, _C; stage_rc(tid * 16 + _i * 8192, _R, _C); const int _r = _h * HALF + _R; \
        int _row; if ((u).rows) { _row = (u).rows[_r]; _row = _row < 0 ? 0 : _row; } else _row = (u).row0 + _r; (vo)[_h][_i] = (unsigned)_row * (unsigned)(lda * 2) + (unsigned)(_C * 2) + (unsigned)(u).aoff; } } while (0)
    Unit cur, nxt; int ui = 0;
    if (!S.next(0, cur)) return;
    unsigned vc[2][2];
    PG8_MKVO(cur, vc);
    f32x4 acc[2][2][4][2];
#pragma unroll
    for (int a = 0; a < 2; ++a)
#pragma unroll
        for (int b = 0; b < 2; ++b)
#pragma unroll
            for (int m = 0; m < 4; ++m)
#pragma unroll
                for (int n = 0; n < 2; ++n) acc[a][b][m][n] = (f32x4){0.f, 0.f, 0.f, 0.f};
    bf16x8 At[4][2], B0[2][2], B1[2][2];
    const char* cB = cur.B;
    PG8_STAGE_B(PG8_SB(0, 0), cB); PG8_STAGE_B(PG8_SB(0, 1), cB + hstep); PG8_STAGE_A(PG8_SA(0, 0), VC0, 0); PG8_STAGE_A(PG8_SA(0, 1), VC1, 0);
    if (wr == 1) PG8_BAR;
    PG8_WAIT_V(2); PG8_BAR;
    PG8_STAGE_B(PG8_SB(1, 0), cB + kstep); PG8_STAGE_A(PG8_SA(1, 0), VC0, kstep); PG8_STAGE_B(PG8_SB(1, 1), cB + hstep + kstep);
    PG8_WAIT_V(6); PG8_BAR;
    for (;;) {
        const bool has_next = S.next(ui + 1, nxt);
        { unsigned vt[2][2];
          if (has_next) { PG8_MKVO(nxt, vt); } else { vt[0][0] = vc[0][0]; vt[0][1] = vc[0][1]; vt[1][0] = vc[1][0]; vt[1][1] = vc[1][1]; }
          *park = (u32x4){vt[0][0], vt[0][1], vt[1][0], vt[1][1]}; }
        const char* nB = has_next ? nxt.B : cB;
#pragma unroll 1
        for (int t = 0; t < nt; t += 2) {
            const bool last = (t == nt - 2);
            const size_t ka1 = (size_t)(t + 1) * kstep;
            const size_t k2 = last ? 0 : (size_t)(t + 2) * kstep, k3 = k2 + kstep;
            const char* b2 = last ? nB : cB + (size_t)(t + 2) * kstep; const char* b3 = b2 + kstep;
            PG8_LDB(B0, 0, 0); PG8_LDB(B1, 0, 1); PG8_SCHED; PG8_LDA(At, 0, 0); PG8_STAGE_A(PG8_SA(1, 1), VC1, ka1);
            if (last) { const u32x4 pv = *park; vc[0][0] = pv.x; vc[0][1] = pv.y; vc[1][0] = pv.z; vc[1][1] = pv.w; }
            PG8_WAIT_V(8); PG8_WAIT_L(0); PG8_BAR; PG8_MMA(0, 0, At, B0); PG8_MMA(0, 1, At, B1); PG8_BAR; PG8_SCHED;
            PG8_LDA(At, 0, 1); PG8_STAGE_B(PG8_SB(0, 0), b2); PG8_STAGE_B(PG8_SB(0, 1), b2 + hstep); PG8_STAGE_A(PG8_SA(0, 0), V20, k2);
            PG8_WAIT_V(8); PG8_WAIT_L(0); PG8_BAR; PG8_MMA(1, 0, At, B0); PG8_MMA(1, 1, At, B1); PG8_BAR; PG8_SCHED;
            PG8_LDB(B0, 1, 0); PG8_LDB(B1, 1, 1); PG8_SCHED; PG8_LDA(At, 1, 0); PG8_STAGE_A(PG8_SA(0, 1), V21, k2);
            PG8_WAIT_V(8); PG8_WAIT_L(0); PG8_BAR; PG8_MMA(0, 0, At, B0); PG8_MMA(0, 1, At, B1); PG8_BAR; PG8_SCHED;
            PG8_LDA(At, 1, 1); PG8_STAGE_B(PG8_SB(1, 0), b3); PG8_STAGE_B(PG8_SB(1, 1), b3 + hstep); PG8_STAGE_A(PG8_SA(1, 0), V20, k3);
            PG8_WAIT_V(8); PG8_WAIT_L(0); PG8_BAR; PG8_MMA(1, 0, At, B0); PG8_MMA(1, 1, At, B1); PG8_BAR; PG8_SCHED;
        }
        if (wr == 0) PG8_BAR;
        E(acc, cur, wr, wc, fr, fq);
        if (!has_next) break;
#pragma unroll
        for (int a = 0; a < 2; ++a)
#pragma unroll
            for (int b = 0; b < 2; ++b)
#pragma unroll
                for (int m = 0; m < 4; ++m)
#pragma unroll
                    for (int n = 0; n < 2; ++n) acc[a][b][m][n] = (f32x4){0.f, 0.f, 0.f, 0.f};
        cur = nxt; cB = nB; ++ui;
        if (wr == 1) PG8_BAR;
    }
    PG8_WAIT_V(0);
    PG8_BAR;
#undef PG8_SA
#undef PG8_SB
#undef PG8_STAGE_A
#undef PG8_STAGE_B
#undef PG8_LDA
#undef PG8_LDB
#undef PG8_MMA
#undef PG8_WAIT_V
#undef PG8_WAIT_L
#undef PG8_BAR
#undef PG8_SCHED
#undef PG8_MKVO
#undef VC0
#undef VC1
#undef V20
#undef V21
}
struct EpiProj {
    bf16_t* O; float* AB;
    __device__ __forceinline__ void operator()(const f32x4 (&acc)[2][2][4][2], const Unit& u, int wr, int wc, int fr, int fq) const {
#pragma unroll
        for (int ai = 0; ai < 2; ++ai)
#pragma unroll
            for (int m = 0; m < 4; ++m) { const int r = u.row0 + ai * HALF + wr * 64 + m * 16 + fr;
#pragma unroll
                for (int bj = 0; bj < 2; ++bj) { const int c = u.col0 + bj * HALF + wc * 32 + 8 * fq; const f32x4 v0 = acc[ai][bj][m][0], v1 = acc[ai][bj][m][1];
                    if (c < PJ) { u32x4 w; w.x = cvt_pk_bf16(v0[0], v0[1]); w.y = cvt_pk_bf16(v0[2], v0[3]); w.z = cvt_pk_bf16(v1[0], v1[1]); w.w = cvt_pk_bf16(v1[2], v1[3]); *(u32x4*)(O + (size_t)r * NPJ + c) = w; }
                    if (c >= 4 * GW && c < 4 * GW + 4 * GH) { *(f32x4*)(AB + (size_t)r * 32 + (c - 4 * GW)) = v0; *(f32x4*)(AB + (size_t)r * 32 + (c - 4 * GW) + 4) = v1; } } }
    }
};
template <bool FIRST> struct EpiResid {
    float* X; const float* g; const float* xl; const float* xc;
    __device__ __forceinline__ void operator()(const f32x4 (&acc)[2][2][4][2], const Unit& u, int wr, int wc, int fr, int fq) const {
#pragma unroll
        for (int ai = 0; ai < 2; ++ai)
#pragma unroll
            for (int m = 0; m < 4; ++m) { const int r = u.row0 + ai * HALF + wr * 64 + m * 16 + fr; const float* gr = g + (size_t)tok_modrow(r) * 6 * D;
#pragma unroll
                for (int bj = 0; bj < 2; ++bj)
#pragma unroll
                    for (int n = 0; n < 2; ++n) { const int c = u.col0 + bj * HALF + wc * 32 + 8 * fq + 4 * n; f32x4* xp = (f32x4*)(X + (size_t)r * D + c); const f32x4 gv = *(const f32x4*)(gr + c);
                        const f32x4 xin = FIRST ? *(const f32x4*)((r < NL ? xl + (size_t)r * D : xc + (size_t)(r - NL) * D) + c) : *xp; *xp = xin + gv * acc[ai][bj][m][n]; } }
    }
};
struct EpiAct {
    bf16_t* O;
    __device__ __forceinline__ void operator()(const f32x4 (&acc)[2][2][4][2], const Unit& u, int wr, int wc, int fr, int fq) const {
#pragma unroll
        for (int ai = 0; ai < 2; ++ai)
#pragma unroll
            for (int m = 0; m < 4; ++m) { const int r = u.row0 + ai * HALF + wr * 64 + m * 16 + fr;
#pragma unroll
                for (int bj = 0; bj < 2; ++bj) { const int c = u.col0 + bj * HALF + wc * 32 + 8 * fq; const f32x4 v0 = acc[ai][bj][m][0], v1 = acc[ai][bj][m][1];
                    u32x2 w; w.x = cvt_pk_bf16(siluf(v0[0]) * v0[1], siluf(v0[2]) * v0[3]); w.y = cvt_pk_bf16(siluf(v1[0]) * v1[1], siluf(v1[2]) * v1[3]);
                    *(u32x2*)(O + (size_t)r * HID + (c >> 1)) = w; } }
    }
};
struct EpiY {
    bf16_t* O;
    __device__ __forceinline__ void operator()(const f32x4 (&acc)[2][2][4][2], const Unit& u, int wr, int wc, int fr, int fq) const {
#pragma unroll
        for (int ai = 0; ai < 2; ++ai)
#pragma unroll
            for (int m = 0; m < 4; ++m) { const int r = u.row0 + ai * HALF + wr * 64 + m * 16 + fr;
#pragma unroll
                for (int bj = 0; bj < 2; ++bj) { const int c = u.col0 + bj * HALF + wc * 32 + 8 * fq; const f32x4 v0 = acc[ai][bj][m][0], v1 = acc[ai][bj][m][1];
                    u32x4 w; w.x = cvt_pk_bf16(v0[0], v0[1]); w.y = cvt_pk_bf16(v0[2], v0[3]); w.z = cvt_pk_bf16(v1[0], v1[1]); w.w = cvt_pk_bf16(v1[2], v1[3]); *(u32x4*)(O + (size_t)r * D + c) = w; } }
    }
};
}

__device__ __forceinline__ void transpose_tile(const float* src, int sN, int Nvalid, int k0, int n0, bf16_t* dst, int K, int rmul, int roff, LAS unsigned char* lds) {
    LAS bf16_t* T = (LAS bf16_t*)lds;
    int t = threadIdx.x; asm volatile("" : "+v"(t));
    { const int kk = t >> 3, c8 = (t & 7) * 8; const float* sp = src + (size_t)(k0 + kk) * sN + n0 + c8;
#pragma unroll
      for (int j = 0; j < 8; ++j) { const float v = (n0 + c8 + j) < Nvalid ? sp[j] : 0.f; T[(c8 + j) * 66 + kk] = f2bf(v); } }
    __syncthreads();
    { const int nn = t >> 3, k8 = (t & 7) * 8; const LAS unsigned* tp = (const LAS unsigned*)(T + nn * 66 + k8);
      pg8::u32x4 w; w.x = tp[0]; w.y = tp[1]; w.z = tp[2]; w.w = tp[3];
      *(pg8::u32x4*)(dst + (size_t)((n0 + nn) * rmul + roff) * K + k0 + k8) = w; }
    __syncthreads();
}
__device__ __forceinline__ void ph_wprep(const P& p, LAS unsigned char* lds) {
    const int G = gridDim.x, c = blockIdx.x;
    for (int it = c; it < DEPTH * (D / 64) * (NPJ / 64); it += G) { const int l = it / ((D / 64) * (NPJ / 64)), r = it % ((D / 64) * (NPJ / 64)), kt = r / (NPJ / 64), ntl = r % (NPJ / 64);
        transpose_tile(p.w_in + (size_t)l * D * PJ, PJ, PJ, kt * 64, ntl * 64, p.WinT + (size_t)l * NPJ * D, D, 1, 0, lds); }
    for (int it = c; it < DEPTH * (D / 64) * (D / 64); it += G) { const int l = it / ((D / 64) * (D / 64)), r = it % ((D / 64) * (D / 64)), kt = r / (D / 64), ntl = r % (D / 64);
        transpose_tile(p.w_out + (size_t)l * D * D, D, D, kt * 64, ntl * 64, p.WoutT + (size_t)l * D * D, D, 1, 0, lds); }
}
constexpr int MOE_T13 = NE * 2 * (D / 64) * (HID / 64), MOE_TILES = MOE_T13 + NE * (HID / 64) * (D / 64);
__device__ __forceinline__ void moe_tile(const P& p, int l, int t, LAS unsigned char* lds) {
    if (t < MOE_T13) { const int per = (D / 64) * (HID / 64), le = l * NE + t / (2 * per), r = t % (2 * per), s3 = r / per, q = r % per, kt = q / (HID / 64), ntl = q % (HID / 64);
        transpose_tile((s3 ? p.moe_w3 : p.moe_w1) + (size_t)le * D * HID, HID, HID, kt * 64, ntl * 64, p.W13T + (size_t)le * 2 * HID * D, D, 2, s3, lds); }
    else { const int t2 = t - MOE_T13, per = (HID / 64) * (D / 64), le = l * NE + t2 / per, q = t2 % per, kt = q / (D / 64), ntl = q % (D / 64);
        transpose_tile(p.moe_w2 + (size_t)le * HID * D, D, D, kt * 64, ntl * 64, p.W2T + (size_t)le * D * HID, HID, 1, 0, lds); }
}
__device__ __forceinline__ void moe_batch4(const P& p, int l, int t0, LAS unsigned char* lds) {
    typedef float f32x4 __attribute__((ext_vector_type(4)));
    int t = threadIdx.x; HIDE(t);
    const int kk = t >> 3, c8 = (t & 7) * 8;
    f32x4 v[4][2];
#pragma unroll
    for (int j = 0; j < 4; ++j) { const int tt = t0 + j; const float* sp;
        if (tt < MOE_T13) { const int per = (D / 64) * (HID / 64), le = l * NE + tt / (2 * per), r = tt % (2 * per), s3 = r / per, q = r % per, kt = q / (HID / 64), ntl = q % (HID / 64);
            sp = (s3 ? p.moe_w3 : p.moe_w1) + (size_t)le * D * HID + (size_t)(kt * 64 + kk) * HID + ntl * 64 + c8; }
        else { const int t2 = tt - MOE_T13, per = (HID / 64) * (D / 64), le = l * NE + t2 / per, q = t2 % per, kt = q / (D / 64), ntl = q % (D / 64);
            sp = p.moe_w2 + (size_t)le * HID * D + (size_t)(kt * 64 + kk) * D + ntl * 64 + c8; }
        v[j][0] = *(const f32x4*)sp; v[j][1] = *(const f32x4*)(sp + 4); }
#pragma unroll
    for (int j = 0; j < 4; ++j) { LAS bf16_t* T = (LAS bf16_t*)(lds + j * 8704);
#pragma unroll
        for (int i = 0; i < 8; ++i) T[(c8 + i) * 66 + kk] = f2bf(v[j][i >> 2][i & 3]); }
    __syncthreads();
    const int nn = t >> 3, k8 = (t & 7) * 8;
#pragma unroll
    for (int j = 0; j < 4; ++j) { const int tt = t0 + j; bf16_t* dp;
        if (tt < MOE_T13) { const int per = (D / 64) * (HID / 64), le = l * NE + tt / (2 * per), r = tt % (2 * per), s3 = r / per, q = r % per, kt = q / (HID / 64), ntl = q % (HID / 64);
            dp = p.W13T + (size_t)le * 2 * HID * D + (size_t)((ntl * 64 + nn) * 2 + s3) * D + kt * 64 + k8; }
        else { const int t2 = tt - MOE_T13, per = (HID / 64) * (D / 64), le = l * NE + t2 / per, q = t2 % per, kt = q / (D / 64), ntl = q % (D / 64);
            dp = p.W2T + (size_t)le * D * HID + (size_t)(ntl * 64 + nn) * HID + kt * 64 + k8; }
        const LAS unsigned* tp = (const LAS unsigned*)((LAS bf16_t*)(lds + j * 8704) + nn * 66 + k8);
        pg8::u32x4 w; w.x = tp[0]; w.y = tp[1]; w.z = tp[2]; w.w = tp[3];
        *(pg8::u32x4*)dp = w; }
    __syncthreads();
}
__device__ __forceinline__ void wq_pull(const P& p, int l, int nbatch, LAS unsigned char* lds) {
    if (l >= DEPTH) return;
    unsigned* ctr = p.bar + 3712 + l * 32; LAS int* tq = (LAS int*)(lds + 131072 + 48);
    for (int k = 0; nbatch < 0 || k < nbatch; ++k) {
        __syncthreads();
        if (threadIdx.x == 0) *tq = (int)__hip_atomic_fetch_add(ctr, 4u, __ATOMIC_RELAXED, __HIP_MEMORY_SCOPE_AGENT);
        __syncthreads();
        const int t0 = __builtin_amdgcn_readfirstlane(*tq); if (t0 >= MOE_TILES) break;
        moe_batch4(p, l, t0, lds);
    }
}
__device__ __forceinline__ void ph_inproj_mfma(const P& p, int l, LAS unsigned char* lds) {
    pg8::DenseSched S; S.init(NT, NPJ, D, p.WinT + (size_t)l * NPJ * D, gridDim.x, blockIdx.x);
    pg8::EpiProj E{p.PROJb, p.AB};
    pg8::gemm_phase(lds, p.HNb, D, D, D, S, E);
}
__device__ __forceinline__ void ph_outproj_mfma(const P& p, int l, int ntok, LAS unsigned char* lds) {
    pg8::DenseSched S; S.init(ntok, D, D, p.WoutT + (size_t)l * D * D, gridDim.x, blockIdx.x);
    if (l == 0) { pg8::EpiResid<true> E{p.X, p.MOD + (size_t)l * (NB + 1) * 6 * D + 2 * D, p.x, p.ctx}; pg8::gemm_phase(lds, p.MIXb, D, D, D, S, E); }
    else { pg8::EpiResid<false> E{p.X, p.MOD + (size_t)l * (NB + 1) * 6 * D + 2 * D, nullptr, nullptr}; pg8::gemm_phase(lds, p.MIXb, D, D, D, S, E); }
}
__device__ __forceinline__ void ph_moe1_mfma(const P& p, int l, LAS unsigned char* lds) {
    pg8::MoeSched S{(__builtin_amdgcn_readfirstlane(p.OFF[NE * 32 + VZ]) / MBLK) * 4, (int)gridDim.x, (int)blockIdx.x, (const char*)(p.W13T + (size_t)l * NE * 2 * HID * D), (size_t)2 * HID * D * 2, D, p.BLKE, p.SLOT_TOK};
    pg8::EpiAct E{p.ACTb};
    pg8::gemm_phase(lds, p.H2b, D, H2S, D, S, E);
}
__device__ __forceinline__ void ph_moe2_mfma(const P& p, int l, LAS unsigned char* lds) {
    pg8::MoeSched S{(__builtin_amdgcn_readfirstlane(p.OFF[NE * 32 + VZ]) / MBLK) * 4, (int)gridDim.x, (int)blockIdx.x, (const char*)(p.W2T + (size_t)l * NE * D * HID), (size_t)D * HID * 2, HID, p.BLKE, nullptr};
    pg8::EpiY E{p.Yb};
    pg8::gemm_phase(lds, p.ACTb, HID, HID, HID, S, E);
}

namespace att {
typedef short bf16x8 __attribute__((ext_vector_type(8)));
typedef float f32x16 __attribute__((ext_vector_type(16)));
typedef unsigned u32x4 __attribute__((ext_vector_type(4)));
typedef unsigned u32x2 __attribute__((ext_vector_type(2)));
constexpr int KROW = 144, VROW = 136, KBUF = 64 * KROW, VBUF = 64 * VROW, VOFF = 2 * KBUF;
typedef float f32x2_t __attribute__((ext_vector_type(2))); typedef __bf16 bf16x2_t __attribute__((ext_vector_type(2)));
__device__ __forceinline__ unsigned pk(float lo, float hi) { const f32x2_t v = {lo, hi}; return __builtin_bit_cast(unsigned, __builtin_convertvector(v, bf16x2_t)); }
__device__ __forceinline__ float ex2(float x) { return __builtin_amdgcn_exp2f(x); }
__device__ __forceinline__ float max3f(float a, float b, float c) { float r; asm("v_max3_f32 %0, %1, %2, %3" : "=v"(r) : "v"(a), "v"(b), "v"(c)); return r; }
}
__device__ __forceinline__ void ph_attn_mfma(const P& p, int l, bool need_ctx, LAS unsigned char* lds) {
    using namespace att;
    int tid = threadIdx.x; HIDE(tid);
    const int wid = __builtin_amdgcn_readfirstlane(tid >> 6), lane = tid & 63, r32 = lane & 31, hh = lane >> 5, g = wid >> 1, tsub = wid & 1;
    const int srow = tid >> 3, schunk = tid & 7;
    constexpr int NLU = NB * AKH * (SEQ / 64), NCU = NB * AKH * (CTX / 64);
    const int nunits = NLU + (need_ctx ? NCU : 0);
    unsigned* qctr = p.bar + 3584 + l * 32; LAS int* uq = (LAS int*)(lds + 131072 + 32);
    for (;;) {
        __syncthreads();
        if (threadIdx.x == 0) *uq = (int)__hip_atomic_fetch_add(qctr, 1u, __ATOMIC_RELAXED, __HIP_MEMORY_SCOPE_AGENT);
        __syncthreads();
        const int u = *uq; if (u >= nunits) break;
        int b, kvh, tok0, kk0, ntiles;
        if (u < NLU) { b = u / (AKH * (SEQ / 64)); kvh = (u / (SEQ / 64)) % AKH; tok0 = b * SEQ + (u % (SEQ / 64)) * 64; kk0 = 0; ntiles = KK / 64; }
        else { const int v = u - NLU; b = v / (AKH * (CTX / 64)); kvh = (v / (CTX / 64)) % AKH; tok0 = NL + b * CTX + (v % (CTX / 64)) * 64; kk0 = SEQ; ntiles = CTX / 64; }
        const int hq = kvh * AG + g, token = tok0 + tsub * 32 + r32;
        bf16x8 qf[4];
        { const bf16_t* qrow = p.AQb + (size_t)token * AW + hq * HD + hh * 8;
#pragma unroll
          for (int s = 0; s < 4; ++s) qf[s] = *(const bf16x8*)(qrow + s * 16); }
        f32x16 o0, o1;
#pragma unroll
        for (int i = 0; i < 16; ++i) { o0[i] = 0.f; o1[i] = 0.f; }
        float m = -1e30f, lsum = 0.f;
        const bf16_t* Kg = p.Kc + ((size_t)(b * AKH + kvh) * KK + kk0 + srow) * HD + schunk * 8;
        const bf16_t* Vg = p.Vt + ((size_t)(b * AKH + kvh) * HD + srow) * KK + kk0 + schunk * 8;
        u32x4 kA = *(const u32x4*)Kg, vA = *(const u32x4*)Vg, kB = *(const u32x4*)(Kg + (size_t)64 * HD), vB = *(const u32x4*)(Vg + 64);
#define ATT_STORE(kr, vr, buf) do { LAS unsigned char* kb_ = lds + (buf) * KBUF + srow * KROW + schunk * 16; LAS unsigned char* vb_ = lds + VOFF + (buf) * VBUF + srow * VROW + schunk * 16; \
            *(LAS u32x4*)kb_ = (kr); *(LAS u32x2*)vb_ = (u32x2){(vr).x, (vr).y}; *(LAS u32x2*)(vb_ + 8) = (u32x2){(vr).z, (vr).w}; } while (0)
        ATT_STORE(kA, vA, 0);
        __syncthreads();
#define ATT_TILE(cur) do { \
            LAS unsigned char* Kb = lds + cur * KBUF; LAS unsigned char* Vb = lds + VOFF + cur * VBUF; \
            f32x16 s0, s1; \
_Pragma("unroll") \
            for (int i = 0; i < 16; ++i) { s0[i] = 0.f; s1[i] = 0.f; } \
_Pragma("unroll") \
            for (int s = 0; s < 4; ++s) { \
                const bf16x8 a0 = *(const LAS bf16x8*)(Kb + r32 * KROW + s * 32 + hh * 16), a1 = *(const LAS bf16x8*)(Kb + (r32 + 32) * KROW + s * 32 + hh * 16); \
                s0 = __builtin_amdgcn_mfma_f32_32x32x16_bf16(a0, qf[s], s0, 0, 0, 0); \
                s1 = __builtin_amdgcn_mfma_f32_32x32x16_bf16(a1, qf[s], s1, 0, 0, 0); \
            } \
            float mx = max3f(s0[0], s1[0], s0[1]); \
_Pragma("unroll") \
            for (int i = 1; i < 15; ++i) mx = max3f(mx, s1[i], s0[i + 1]); \
            mx = max3f(mx, s1[15], __shfl_xor(max3f(mx, s1[15], s1[15]), 32)); \
            if (__ballot(mx > m + 8.0f) != 0ull) {        \
                const float mn = max3f(m, mx, mx), alpha = ex2(m - mn); m = mn; lsum *= alpha; \
_Pragma("unroll") \
                for (int i = 0; i < 16; ++i) { o0[i] *= alpha; o1[i] *= alpha; } \
            } \
            float rs = 0.f; \
_Pragma("unroll") \
            for (int i = 0; i < 16; ++i) { s0[i] = ex2(s0[i] - m); s1[i] = ex2(s1[i] - m); rs += s0[i] + s1[i]; } \
            lsum += rs; \
            bf16x8 pf[4]; \
_Pragma("unroll") \
            for (int s = 0; s < 2; ++s) { \
                u32x4 w0, w1; \
                w0.x = pk(s0[8 * s + 0], s0[8 * s + 1]); w0.y = pk(s0[8 * s + 2], s0[8 * s + 3]); w0.z = pk(s0[8 * s + 4], s0[8 * s + 5]); w0.w = pk(s0[8 * s + 6], s0[8 * s + 7]); \
                w1.x = pk(s1[8 * s + 0], s1[8 * s + 1]); w1.y = pk(s1[8 * s + 2], s1[8 * s + 3]); w1.z = pk(s1[8 * s + 4], s1[8 * s + 5]); w1.w = pk(s1[8 * s + 6], s1[8 * s + 7]); \
                pf[s] = __builtin_bit_cast(bf16x8, w0); pf[2 + s] = __builtin_bit_cast(bf16x8, w1); \
            } \
_Pragma("unroll") \
            for (int t = 0; t < 2; ++t) \
_Pragma("unroll") \
                for (int s = 0; s < 2; ++s) { \
                    const int kb2 = (32 * t + 16 * s + 4 * hh) * 2; \
                    const LAS unsigned char* v0p = Vb + r32 * VROW + kb2; const LAS unsigned char* v1p = Vb + (r32 + 32) * VROW + kb2; \
                    const u32x2 l0 = *(const LAS u32x2*)v0p, h0 = *(const LAS u32x2*)(v0p + 16), l1 = *(const LAS u32x2*)v1p, h1 = *(const LAS u32x2*)(v1p + 16); \
                    const bf16x8 av0 = __builtin_bit_cast(bf16x8, (u32x4){l0.x, l0.y, h0.x, h0.y}), av1 = __builtin_bit_cast(bf16x8, (u32x4){l1.x, l1.y, h1.x, h1.y}); \
                    o0 = __builtin_amdgcn_mfma_f32_32x32x16_bf16(av0, pf[2 * t + s], o0, 0, 0, 0); \
                    o1 = __builtin_amdgcn_mfma_f32_32x32x16_bf16(av1, pf[2 * t + s], o1, 0, 0, 0); \
                } \
        } while (0)
        static_assert((KK / 64) % 2 == 0 && (CTX / 64) % 2 == 0, "the tile loop is unrolled by two");
        for (int j = 0; j < ntiles; j += 2) {
            if (j + 2 < ntiles) { kA = *(const u32x4*)(Kg + (size_t)(j + 2) * 64 * HD); vA = *(const u32x4*)(Vg + (j + 2) * 64); }
            ATT_TILE(0);
            ATT_STORE(kB, vB, 1);
            __syncthreads();
            if (j + 3 < ntiles) { kB = *(const u32x4*)(Kg + (size_t)(j + 3) * 64 * HD); vB = *(const u32x4*)(Vg + (j + 3) * 64); }
            ATT_TILE(1);
            if (j + 2 < ntiles) ATT_STORE(kA, vA, 0);
            __syncthreads();
        }
#undef ATT_TILE
#undef ATT_STORE
        lsum += __shfl_xor(lsum, 32);
        const float inv = 1.0f / lsum;
        bf16_t* op = p.MIXb + (size_t)token * D + GW + LW + hq * HD + 4 * hh;
#pragma unroll
        for (int q = 0; q < 4; ++q) {
            *(u32x2*)(op + 8 * q) = (u32x2){pk(o0[4 * q] * inv, o0[4 * q + 1] * inv), pk(o0[4 * q + 2] * inv, o0[4 * q + 3] * inv)};
            *(u32x2*)(op + 32 + 8 * q) = (u32x2){pk(o1[4 * q] * inv, o1[4 * q + 1] * inv), pk(o1[4 * q + 2] * inv, o1[4 * q + 3] * inv)};
        }
    }
}
constexpr int NCP = NB * GH * 2 * NCH;
__device__ __forceinline__ int frag_off(int i, int k) { return ((((i >> 5) * 4 + (k >> 4)) * 64 + (((k >> 2) & 1) * 32 + (i & 31))) * 8) + ((k >> 3) & 1) * 4 + (k & 3); }
__device__ __forceinline__ att::bf16x8 cvt8(const float* q) {
    const pg8::f32x4 a = *(const pg8::f32x4*)q, b = *(const pg8::f32x4*)(q + 4);
    att::u32x4 w; w.x = att::pk(a[0], a[1]); w.y = att::pk(a[2], a[3]); w.z = att::pk(b[0], b[1]); w.w = att::pk(b[2], b[3]);
    return __builtin_bit_cast(att::bf16x8, w);
}
__device__ __forceinline__ att::bf16x8 pack8(const att::f32x16& v, int o) {
    att::u32x4 w; w.x = att::pk(v[o], v[o + 1]); w.y = att::pk(v[o + 2], v[o + 3]); w.z = att::pk(v[o + 4], v[o + 5]); w.w = att::pk(v[o + 6], v[o + 7]);
    return __builtin_bit_cast(att::bf16x8, w);
}
template <int I> __device__ __forceinline__ void gdn_solve_block(float (&x)[64], const LAS float* At) {
#pragma unroll
    for (int j = 0; j < 16 * I; ++j) {
        const LAS pg8::f32x4* ap = (const LAS pg8::f32x4*)(At + j * 64 + 16 * I);
        const float xj = x[j];
#pragma unroll
        for (int q = 0; q < 4; ++q) { const pg8::f32x4 a4 = ap[q]; x[16 * I + 4 * q] -= a4[0] * xj; x[16 * I + 4 * q + 1] -= a4[1] * xj; x[16 * I + 4 * q + 2] -= a4[2] * xj; x[16 * I + 4 * q + 3] -= a4[3] * xj; }
    }
#pragma unroll
    for (int r2 = 0; r2 < 15; ++r2) {
        const LAS pg8::f32x4* ap = (const LAS pg8::f32x4*)(At + (16 * I + r2) * 64 + 16 * I);
#pragma unroll
        for (int q = 0; q < 4; ++q) { if (4 * q + 3 > r2) { const pg8::f32x4 a4 = ap[q];
#pragma unroll
            for (int e = 0; e < 4; ++e) if (4 * q + e > r2) x[16 * I + 4 * q + e] -= a4[e] * x[16 * I + r2]; } }
    }
}
template <int PASS> __device__ __forceinline__ void gdn_pass(LAS float* At, const LAS int* nL, const LAS float* btL, const LAS float* egL, const bf16_t* colbase, float* Uo, bf16_t* Wo, int lane) {
    asm volatile("" ::: "memory");
    float x[64];
#pragma unroll
    for (int i = 0; i < 64; ++i) { const bf16_t* row = colbase + (size_t)nL[i] * 3 * GW; x[i] = PASS ? btL[i] * egL[i] * bf2f(row[GW]) : btL[i] * bf2f(row[2 * GW]); }
    gdn_solve_block<0>(x, At); gdn_solve_block<1>(x, At); gdn_solve_block<2>(x, At); gdn_solve_block<3>(x, At);
    const int r32 = lane & 31, hh = lane >> 5;
    if (PASS == 0) {
#pragma unroll
        for (int i = 0; i < 64; i += 4) { const int rr = i & 31;
            *(pg8::f32x4*)(Uo + (((i >> 5) * 2 + hh) * 64 + (((rr >> 2) & 1) * 32 + r32)) * 16 + 4 * (rr >> 3)) = (pg8::f32x4){x[i], x[i + 1], x[i + 2], x[i + 3]}; }
    } else {
        LAS bf16_t* T = (LAS bf16_t*)At;
#pragma unroll
        for (int i = 0; i < 64; ++i) T[frag_off(i, lane)] = f2bf(-x[i]);
#pragma unroll
        for (int c = 0; c < 8; ++c) *(pg8::u32x4*)(Wo + (c * 64 + lane) * 8) = *(const LAS pg8::u32x4*)(T + (c * 64 + lane) * 8);
    }
}
__device__ __forceinline__ void ph_gdn_a(const P& p, int l, LAS unsigned char* lds) {
    using namespace att;
    int tid = threadIdx.x; HIDE(tid);
    const int wid = __builtin_amdgcn_readfirstlane(tid >> 6);
    LAS float* At = (LAS float*)(lds + wid * 16384);
    LAS float* gcL = (LAS float*)(lds + 131072 + 64 + wid * 1024);
    LAS float* btL = gcL + 64; LAS float* egL = gcL + 128; LAS int* nL = (LAS int*)(gcL + 192);
    const int per_wg = (NCP + (int)gridDim.x - 1) / (int)gridDim.x;
    for (int q = wid; q < per_wg; q += 8) { const int cp = blockIdx.x * per_wg + q; if (cp >= NCP) break;
        int lane = tid & 63; HIDE(lane);
        const int r32 = lane & 31, hh = lane >> 5;
        const int ci = cp % NCH, dir = (cp / NCH) % 2, h = (cp / (2 * NCH)) % GH, b = cp / (2 * NCH * GH);
        const int n = chunk_tok(b, dir, ci, lane);
        const float bt = p.GB[(size_t)n * 2 * GH + dir * GH + h];
        float gc = p.GG[(size_t)n * 2 * GH + dir * GH + h];
#pragma unroll
        for (int off = 1; off < 64; off <<= 1) { const float t = __shfl_up(gc, off); if (lane >= off) gc += t; }
        const float gl = __shfl(gc, 63);
        gcL[lane] = gc; btL[lane] = bt; egL[lane] = fexp(gc); nL[lane] = n;
        bf16x8 kf[2][4], qf[2][4];
#pragma unroll
        for (int blk = 0; blk < 2; ++blk) { const int nr = __shfl(n, blk * 32 + r32); const bf16_t* base = (const bf16_t*)p.GQKV + (size_t)nr * 3 * GW + h * HD + 8 * hh;
#pragma unroll
            for (int s = 0; s < 4; ++s) { qf[blk][s] = *(const bf16x8*)(base + 16 * s); kf[blk][s] = *(const bf16x8*)(base + GW + 16 * s); } }
        bf16_t* QKo = p.GQK + (size_t)cp * 4096;
#pragma unroll
        for (int tl = 0; tl < 3; ++tl) {
            const int rb = tl > 0, cb = tl > 1;
            f32x16 ak, aq;
#pragma unroll
            for (int i = 0; i < 16; ++i) { ak[i] = 0.f; aq[i] = 0.f; }
#pragma unroll
            for (int s = 0; s < 4; ++s) { ak = __builtin_amdgcn_mfma_f32_32x32x16_bf16(kf[rb][s], kf[cb][s], ak, 0, 0, 0); aq = __builtin_amdgcn_mfma_f32_32x32x16_bf16(qf[rb][s], kf[cb][s], aq, 0, 0, 0); }
            const int j = cb * 32 + r32; const float gcj = gcL[j];
#pragma unroll
            for (int r = 0; r < 16; ++r) {
                const int i = rb * 32 + (r & 3) + 8 * (r >> 2) + 4 * hh;
                const float dec = fexp(j <= i ? gcL[i] - gcj : 0.f);
                At[j * 64 + i] = j < i ? btL[i] * ak[r] * dec : 0.f;
                QKo[frag_off(i, j)] = f2bf(j <= i ? aq[r] * dec : 0.f);
            }
        }
        float* Uo = p.GU + (size_t)cp * 4096; bf16_t* Wo = p.GWN + (size_t)cp * 4096; bf16_t* QGo = p.GQG + (size_t)cp * 4096; bf16_t* KTo = p.GKT + (size_t)cp * 4096;
        const bf16_t* colbase = (const bf16_t*)p.GQKV + h * HD + lane;
        gdn_pass<0>(At, nL, btL, egL, colbase, Uo, Wo, lane); gdn_pass<1>(At, nL, btL, egL, colbase, Uo, Wo, lane);
#pragma unroll 1
        for (int i0 = 0; i0 < 64; i0 += 16) {
            float qv[16], kv[16];
#pragma unroll
            for (int i = 0; i < 16; ++i) { const bf16_t* row = colbase + (size_t)nL[i0 + i] * 3 * GW; qv[i] = bf2f(row[0]); kv[i] = bf2f(row[GW]); }
#pragma unroll
            for (int i = 0; i < 16; ++i) { ((LAS bf16_t*)At)[frag_off(i0 + i, lane)] = f2bf(qv[i] * egL[i0 + i]); kv[i] *= fexp(gl - gcL[i0 + i]); }
#pragma unroll
            for (int i = 0; i < 16; i += 4) *(att::u32x2*)(KTo + frag_off(lane, i0 + i)) = (att::u32x2){att::pk(kv[i], kv[i + 1]), att::pk(kv[i + 2], kv[i + 3])};
        }
#pragma unroll
        for (int c = 0; c < 8; ++c) *(pg8::u32x4*)(QGo + (c * 64 + lane) * 8) = *(const LAS pg8::u32x4*)((LAS bf16_t*)At + (c * 64 + lane) * 8);
        if (lane == 0) p.GEL[(size_t)cp * 32] = fexp(gl);
    }
}
__device__ __forceinline__ void ph_gdn_b(const P& p, int l, LAS unsigned char* lds) {
    using namespace att;
    if (blockIdx.x >= NB * GH * 2 * 2) return;
    int tid = threadIdx.x; HIDE(tid);
    const int wid = __builtin_amdgcn_readfirstlane(tid >> 6), lane = tid & 63, r32 = lane & 31, hh = lane >> 5;
    const int wv = blockIdx.x, slice = wv & 1, pr = wv >> 1, dir = pr & 1, h = (pr >> 1) % GH, b = pr / (2 * GH);
    constexpr int SLOT = 40960;
#define GB_ISSUE(ci_, slot_) do { _Pragma("unroll") for (int i_ = 0; i_ < 6; ++i_) { int k_ = (wid - 1) * 6 + i_; k_ = k_ > 39 ? 39 : k_; \
        const size_t cp_ = (size_t)pr * NCH + (ci_); const char* g_; \
        if (k_ < 32) g_ = (const char*)((k_ < 8 ? p.GWN : k_ < 16 ? p.GQG : k_ < 24 ? p.GQK : p.GKT) + cp_ * 4096) + (size_t)(k_ & 7) * 1024 + lane * 16; \
        else g_ = (const char*)(p.GU + cp_ * 4096 + ((((k_ - 32) >> 2) * 2 + slice) * 64 + lane) * 16) + ((k_ - 32) & 3) * 16; \
        __builtin_amdgcn_global_load_lds((const unsigned*)g_, (LAS unsigned*)(lds + (slot_) * SLOT + k_ * 1024), 16, 0, 0); } } while (0)
    f32x16 S0, S1;
#pragma unroll
    for (int i = 0; i < 16; ++i) { S0[i] = 0.f; S1[i] = 0.f; }
    float ev = 0.f;
    if (wid == 0) { if (lane < NCH) ev = p.GEL[((size_t)pr * NCH + lane) * 32]; }
    else { GB_ISSUE(0, 0); GB_ISSUE(1, 1); asm volatile("s_waitcnt vmcnt(6)" ::: "memory"); }
    for (int ci = 0; ci < NCH; ++ci) {
        __builtin_amdgcn_s_barrier(); asm volatile("" ::: "memory");
        if (wid != 0) {
            if (ci + 2 < NCH) { const int sl = (ci + 2) % 3; GB_ISSUE(ci + 2, sl); asm volatile("s_waitcnt vmcnt(6)" ::: "memory"); }
            else asm volatile("s_waitcnt vmcnt(0)" ::: "memory");
            continue;
        }
        const LAS unsigned char* sb = lds + (ci % 3) * SLOT + lane * 16;
#define GB_FR(mat, idx) (*(const LAS bf16x8*)(sb + ((mat) * 8 + (idx)) * 1024))
        f32x16 x0, x1;
#pragma unroll
        for (int q = 0; q < 4; ++q) { const pg8::f32x4 a0 = *(const LAS pg8::f32x4*)(sb + (32 + q) * 1024), a1 = *(const LAS pg8::f32x4*)(sb + (36 + q) * 1024);
            x0[4 * q] = a0[0]; x0[4 * q + 1] = a0[1]; x0[4 * q + 2] = a0[2]; x0[4 * q + 3] = a0[3]; x1[4 * q] = a1[0]; x1[4 * q + 1] = a1[1]; x1[4 * q + 2] = a1[2]; x1[4 * q + 3] = a1[3]; }
        const float e = __builtin_bit_cast(float, __builtin_amdgcn_readlane(__builtin_bit_cast(int, ev), ci));
        bf16x8 sf[4]; sf[0] = pack8(S0, 0); sf[1] = pack8(S0, 8); sf[2] = pack8(S1, 0); sf[3] = pack8(S1, 8);
        f32x16 t0, t1;
#pragma unroll
        for (int i = 0; i < 16; ++i) { t0[i] = 0.f; t1[i] = 0.f; }
#pragma unroll
        for (int s2 = 0; s2 < 4; ++s2) {
            x0 = __builtin_amdgcn_mfma_f32_32x32x16_bf16(GB_FR(0, s2), sf[s2], x0, 0, 0, 0); x1 = __builtin_amdgcn_mfma_f32_32x32x16_bf16(GB_FR(0, 4 + s2), sf[s2], x1, 0, 0, 0);
            t0 = __builtin_amdgcn_mfma_f32_32x32x16_bf16(GB_FR(1, s2), sf[s2], t0, 0, 0, 0); t1 = __builtin_amdgcn_mfma_f32_32x32x16_bf16(GB_FR(1, 4 + s2), sf[s2], t1, 0, 0, 0);
        }
        bf16x8 xf[4]; xf[0] = pack8(x0, 0); xf[1] = pack8(x0, 8); xf[2] = pack8(x1, 0); xf[3] = pack8(x1, 8);
        t0 = __builtin_amdgcn_mfma_f32_32x32x16_bf16(GB_FR(2, 0), xf[0], t0, 0, 0, 0); t0 = __builtin_amdgcn_mfma_f32_32x32x16_bf16(GB_FR(2, 1), xf[1], t0, 0, 0, 0);
#pragma unroll
        for (int s2 = 0; s2 < 4; ++s2) t1 = __builtin_amdgcn_mfma_f32_32x32x16_bf16(GB_FR(2, 4 + s2), xf[s2], t1, 0, 0, 0);
#pragma unroll
        for (int i = 0; i < 16; ++i) { S0[i] *= e; S1[i] *= e; }
#pragma unroll
        for (int s2 = 0; s2 < 4; ++s2) { S0 = __builtin_amdgcn_mfma_f32_32x32x16_bf16(GB_FR(3, s2), xf[s2], S0, 0, 0, 0); S1 = __builtin_amdgcn_mfma_f32_32x32x16_bf16(GB_FR(3, 4 + s2), xf[s2], S1, 0, 0, 0); }
        float* go = p.GO + (size_t)dir * NT * GW + h * HD + slice * 32 + r32;
#pragma unroll
        for (int r = 0; r < 16; ++r) {
            const int c = (r & 3) + 8 * (r >> 2) + 4 * hh;
            go[(size_t)chunk_tok(b, dir, ci, c) * GW] = t0[r]; go[(size_t)chunk_tok(b, dir, ci, 32 + c) * GW] = t1[r];
        }
    }
    __builtin_amdgcn_s_barrier(); asm volatile("" ::: "memory");
#undef GB_ISSUE
#undef GB_FR
}
__device__ __forceinline__ pg8::f32x4 ldb4(const bf16_t* q) { const pg8::u32x2 w = *(const pg8::u32x2*)q; return (pg8::f32x4){__builtin_bit_cast(float, w.x << 16), __builtin_bit_cast(float, w.x & 0xffff0000u), __builtin_bit_cast(float, w.y << 16), __builtin_bit_cast(float, w.y & 0xffff0000u)}; }
__device__ __forceinline__ float wave_sum(float v) {
#pragma unroll
    for (int o = 32; o > 0; o >>= 1) v += __shfl_xor(v, o);
    return v;
}
__device__ __forceinline__ void ph_rownorm(const P& p, int l, int lc, int ntok_c, int nrows) {
    typedef float f32x4 __attribute__((ext_vector_type(4)));
    typedef unsigned u32x2 __attribute__((ext_vector_type(2)));
    int tid = threadIdx.x; HIDE(tid);
    const int lane = tid & 63, wave = blockIdx.x * 8 + (tid >> 6), nwaves = gridDim.x * 8;
    constexpr int R = 3;
    for (int nb = wave * R; nb < nrows; nb += nwaves * R) {
        f32x4 x[R][D / 256], ya[R][D / 256], yb[R][D / 256]; float g0[R], g1[R]; bool comb[R]; int mr[R];
#pragma unroll
        for (int r = 0; r < R; ++r) { const int n = nb + r < nrows ? nb + r : nrows - 1; mr[r] = tok_modrow(n); comb[r] = lc >= 0 && n < ntok_c;
#pragma unroll
            for (int j = 0; j < D / 256; ++j) x[r][j] = *(const f32x4*)((lc < 0 ? (n < NL ? p.x + (size_t)n * D : p.ctx + (size_t)(n - NL) * D) : p.X + (size_t)n * D) + j * 256 + lane * 4); }
        int s0[R], s1[R];
#pragma unroll
        for (int r = 0; r < R; ++r) { const int n = nb + r < nrows ? nb + r : nrows - 1; const int vz = VZ;
            if (comb[r]) { s0[r] = p.SLOT_OF[(size_t)n * 64 + vz]; s1[r] = p.SLOT_OF[(size_t)n * 64 + 32 + vz]; g0[r] = p.RG[n * 2 + vz]; g1[r] = p.RG[n * 2 + 1 + vz]; } else { s0[r] = 0; s1[r] = 0; g0[r] = 0.f; g1[r] = 0.f; } }
#pragma unroll
        for (int r = 0; r < R; ++r)
#pragma unroll
            for (int j = 0; j < D / 256; ++j) { const int o = j * 256 + lane * 4; if (comb[r]) { ya[r][j] = ldb4(p.Yb + (size_t)s0[r] * D + o); yb[r][j] = ldb4(p.Yb + (size_t)s1[r] * D + o); } else { ya[r][j] = (f32x4){0.f, 0.f, 0.f, 0.f}; yb[r][j] = ya[r][j]; } }
#pragma unroll
        for (int r = 0; r < R; ++r) {
            const int n = nb + r; if (n >= nrows) break;
            if (comb[r]) { const float* g2 = p.MOD + ((size_t)lc * (NB + 1) + mr[r]) * 6 * D + 5 * D;
#pragma unroll
                for (int j = 0; j < D / 256; ++j) { const int o = j * 256 + lane * 4; const f32x4 g = *(const f32x4*)(g2 + o); x[r][j] = x[r][j] + g * (ya[r][j] * g0[r] + yb[r][j] * g1[r]); if (l < DEPTH) *(f32x4*)(p.X + (size_t)n * D + o) = x[r][j]; } }
            float ss = 0.f;
#pragma unroll
            for (int j = 0; j < D / 256; ++j) ss += x[r][j][0] * x[r][j][0] + x[r][j][1] * x[r][j][1] + x[r][j][2] * x[r][j][2] + x[r][j][3] * x[r][j][3];
            const float rs = frsq(wave_sum(ss) * (1.0f / D) + EPS);
            if (l < DEPTH) {
                const float* gn = p.norm1_g + l * D; const float* md = p.MOD + ((size_t)l * (NB + 1) + mr[r]) * 6 * D;
#pragma unroll
                for (int j = 0; j < D / 256; ++j) { const int o = j * 256 + lane * 4; const f32x4 g = *(const f32x4*)(gn + o), sh = *(const f32x4*)(md + o), sc = *(const f32x4*)(md + D + o);
                    const f32x4 h = x[r][j] * rs * g * (sc + 1.0f) + sh;
                    *(u32x2*)(p.HNb + (size_t)n * D + o) = (u32x2){att::pk(h[0], h[1]), att::pk(h[2], h[3])}; }
            } else {
#pragma unroll
                for (int j = 0; j < D / 256; ++j) { const int o = j * 256 + lane * 4; const f32x4 g = *(const f32x4*)(p.final_norm_g + o); *(f32x4*)(p.out + (size_t)n * D + o) = x[r][j] * rs * g; }
            }
        }
    }
}
constexpr int MOD_KS = 8;
__device__ __forceinline__ void ph_mod_part(const P& p, LAS unsigned char* lds) {
    int tid = threadIdx.x; HIDE(tid);
    LAS float* SL = (LAS float*)lds;
    for (int i = tid; i < (NB + 1) * D; i += 512) { const int r = i / D, k = i % D; SL[i] = siluf(r < NB ? p.c[r * D + k] : p.c_ctx[k]); }
    __syncthreads();
    for (int it = blockIdx.x * 512 + tid; it < DEPTH * MOD_KS * 6 * D; it += gridDim.x * 512) {
        const int j = it % (6 * D), ks = (it / (6 * D)) % MOD_KS, l = it / (6 * D * MOD_KS);
        float acc[NB + 1];
#pragma unroll
        for (int r = 0; r <= NB; ++r) acc[r] = 0.f;
        const float* w = p.w_ada + ((size_t)l * D + ks * (D / MOD_KS)) * 6 * D + j;
#pragma unroll 8
        for (int k = 0; k < D / MOD_KS; ++k) { const float wv = w[(size_t)k * 6 * D];
#pragma unroll
            for (int r = 0; r <= NB; ++r) acc[r] += SL[r * D + ks * (D / MOD_KS) + k] * wv; }
#pragma unroll
        for (int r = 0; r <= NB; ++r) p.PART[(((size_t)ks * DEPTH + l) * (NB + 1) + r) * 6 * D + j] = acc[r];
    }
    __syncthreads();
}
__device__ __forceinline__ void ph_mod_reduce(const P& p) {
    int tid = threadIdx.x; HIDE(tid);
    for (int it = blockIdx.x * 512 + tid; it < DEPTH * (NB + 1) * 6 * D; it += gridDim.x * 512) {
        const int j = it % (6 * D), l = it / (6 * D * (NB + 1));
        float a = p.b_ada[l * 6 * D + j];
#pragma unroll
        for (int ks = 0; ks < MOD_KS; ++ks) a += p.PART[(size_t)ks * DEPTH * (NB + 1) * 6 * D + it];
        p.MOD[it] = a;
    }
}
__device__ __forceinline__ void ph_norm2_w(const P& p, int l, int ntok) {
    typedef float f32x4 __attribute__((ext_vector_type(4)));
    typedef unsigned u32x2 __attribute__((ext_vector_type(2)));
    int tid = threadIdx.x; HIDE(tid);
    const int lane = tid & 63, wave = blockIdx.x * 8 + (tid >> 6), nwaves = gridDim.x * 8;
    constexpr int R = 3;
    for (int nb = wave * R; nb < ntok; nb += nwaves * R) {
        f32x4 x[R][D / 256];
#pragma unroll
        for (int r = 0; r < R; ++r) { const int n = nb + r < ntok ? nb + r : ntok - 1;
#pragma unroll
            for (int j = 0; j < D / 256; ++j) x[r][j] = *(const f32x4*)(p.X + (size_t)n * D + j * 256 + lane * 4); }
#pragma unroll
        for (int r = 0; r < R; ++r) {
            const int n = nb + r; if (n >= ntok) break;
            float ss = 0.f;
#pragma unroll
            for (int j = 0; j < D / 256; ++j) ss += x[r][j][0] * x[r][j][0] + x[r][j][1] * x[r][j][1] + x[r][j][2] * x[r][j][2] + x[r][j][3] * x[r][j][3];
            const float rs = frsq(wave_sum(ss) * (1.0f / D) + EPS);
            const float* gn = p.norm2_g + l * D; const float* md = p.MOD + ((size_t)l * (NB + 1) + tok_modrow(n)) * 6 * D + 3 * D;
            bf16_t* hb = p.H2b + (size_t)n * H2S;
#pragma unroll
            for (int j = 0; j < D / 256; ++j) { const int o = j * 256 + lane * 4; const f32x4 g = *(const f32x4*)(gn + o), sh = *(const f32x4*)(md + o), sc = *(const f32x4*)(md + D + o);
                const f32x4 h = x[r][j] * rs * g * (sc + 1.0f) + sh;
                const u32x2 hi = (u32x2){att::pk(h[0], h[1]), att::pk(h[2], h[3])};
                const float r0 = h[0] - __builtin_bit_cast(float, hi.x << 16), r1 = h[1] - __builtin_bit_cast(float, hi.x & 0xffff0000u), r2 = h[2] - __builtin_bit_cast(float, hi.y << 16), r3 = h[3] - __builtin_bit_cast(float, hi.y & 0xffff0000u);
                const u32x2 lo = (u32x2){att::pk(r0, r1), att::pk(r2, r3)};
                *(u32x2*)(hb + o) = hi; *(u32x2*)(hb + D + o) = lo; }
        }
    }
}
__device__ __forceinline__ void ph_wr_prep(const P& p) {
    int tid = threadIdx.x; HIDE(tid);
    for (int it = blockIdx.x * 512 + tid; it < DEPTH * 256 * D; it += gridDim.x * 512) {
        const int k = it % D, j = (it / D) % 256, l = it / (D * 256);
        float w = 0.f; if (j < NG) w = p.moe_w_group[((size_t)l * D + k) * NG + j]; else if (j < NLOG) w = p.moe_w_expert[((size_t)l * D + k) * NE + (j - NG)];
        const bf16_t hi = f2bf(w), lo = f2bf(w - bf2f(hi));
        bf16_t* o = p.WrT + ((size_t)l * 256 + j) * H2S + k; o[0] = hi; o[D] = hi; o[2 * D] = lo;
    }
}
namespace pg8 {
struct EpiLogit {
    float* O;
    __device__ __forceinline__ void operator()(const f32x4 (&acc)[2][2][4][2], const Unit& u, int wr, int wc, int fr, int fq) const {
#pragma unroll
        for (int ai = 0; ai < 2; ++ai)
#pragma unroll
            for (int m = 0; m < 4; ++m) { const int r = u.row0 + ai * HALF + wr * 64 + m * 16 + fr;
#pragma unroll
                for (int n = 0; n < 2; ++n) { const int c = wc * 32 + 8 * fq + 4 * n; if (c < NLOG) *(f32x4*)(O + (size_t)r * 128 + c) = acc[ai][0][m][n]; } }
    }
};
}
namespace pg8 {
struct RouteSched {
    int nunits, G, c; const char* Bt;
    __device__ bool next(int i, Unit& u) const {
        const long L = (long)i * G + c; if (L >= nunits) return false;
        const int pm = (int)(L / 3), part = (int)(L % 3);
        u.row0 = pm * BM; u.col0 = part; u.B = Bt + (size_t)part * D * 2; u.rows = nullptr; u.aoff = (part == 2 ? 0 : part) * D * 2; return true;
    }
};
struct EpiLogitP {
    float* O;
    __device__ __forceinline__ void operator()(const f32x4 (&acc)[2][2][4][2], const Unit& u, int wr, int wc, int fr, int fq) const {
        float* Op = O + (size_t)u.col0 * NT * 128;
#pragma unroll
        for (int ai = 0; ai < 2; ++ai)
#pragma unroll
            for (int m = 0; m < 4; ++m) { const int r = u.row0 + ai * HALF + wr * 64 + m * 16 + fr;
#pragma unroll
                for (int n = 0; n < 2; ++n) { const int c = wc * 32 + 8 * fq + 4 * n; if (c < NLOG) *(f32x4*)(Op + (size_t)r * 128 + c) = acc[ai][0][m][n]; } }
    }
};
}
__device__ __forceinline__ void ph_rgemm(const P& p, int l, int ntok, LAS unsigned char* lds) {
    pg8::RouteSched S{(ntok / 256) * 3, (int)gridDim.x, (int)blockIdx.x, (const char*)(p.WrT + (size_t)l * 256 * H2S)};
    pg8::EpiLogitP E{p.LOGIT};
    pg8::gemm_phase(lds, p.H2b, D, H2S, H2S, S, E);
}
__device__ __forceinline__ void ph_topk(const P& p, int l, int ntok, LAS unsigned char* lds) {
    int tid = threadIdx.x; HIDE(tid);
    LAS int* hist = (LAS int*)lds;
    if (tid < NE) hist[tid] = 0;
    __syncthreads();
    for (int chunk = blockIdx.x + (tid >> 6) * gridDim.x; chunk * 64 < ntok; chunk += 8 * gridDim.x) { const int n = chunk * 64 + (tid & 63);
    if (n < ntok) {
        const float* lg = p.LOGIT + (size_t)n * 128; const float* lg1 = lg + (size_t)NT * 128; const float* lg2 = lg1 + (size_t)NT * 128;
        float g[NG]; int gi = 0;
#pragma unroll
        for (int j = 0; j < NG; ++j) g[j] = ((lg[j] + lg1[j]) + lg2[j]) + p.moe_b_group[l * NG + j];
        float gm = g[0];
#pragma unroll
        for (int j = 1; j < NG; ++j) if (g[j] > gm) { gm = g[j]; gi = j; }
        float gs = 0.f;
#pragma unroll
        for (int j = 0; j < NG; ++j) gs += fexp(g[j] - gm);
        float e1 = -1e30f, e2 = -1e30f; int i1 = 0, i2 = 0;
#pragma unroll
        for (int j = 0; j < EPG; ++j) { const float v = ((lg[NG + gi * EPG + j] + lg1[NG + gi * EPG + j]) + lg2[NG + gi * EPG + j]) + p.moe_b_expert[l * NE + gi * EPG + j]; if (v > e1) { e2 = e1; i2 = i1; e1 = v; i1 = j; } else if (v > e2) { e2 = v; i2 = j; } }
        const float w2 = fexp(e2 - e1), inv = 1.f / (1.f + w2), pg = 1.f / gs;
        const int ex0 = gi * EPG + i1, ex1 = gi * EPG + i2;
        p.RE[n * 2] = ex0; p.RE[n * 2 + 1] = ex1; p.RG[n * 2] = pg * inv; p.RG[n * 2 + 1] = pg * w2 * inv;
        __hip_atomic_fetch_add(hist + ex0, 1, __ATOMIC_RELAXED, __HIP_MEMORY_SCOPE_WORKGROUP); __hip_atomic_fetch_add(hist + ex1, 1, __ATOMIC_RELAXED, __HIP_MEMORY_SCOPE_WORKGROUP);
    } }
    __syncthreads();
    if (tid < NE) { const int c = hist[tid]; if (c) atomicAdd(&p.CNT[tid], c); }
    __syncthreads();
}
__device__ __forceinline__ void ph_slots_off_w(const P& p, int ntok) {
    int tid = threadIdx.x; HIDE(tid);
    const int lane = tid & 63, e = blockIdx.x * 8 + (tid >> 6);
    if (e >= NE) return;
    const int padl = (p.CNT[lane] + MBLK - 1) / MBLK * MBLK;
    int incl = padl;
#pragma unroll
    for (int o = 1; o < 64; o <<= 1) { const int t = __shfl_up(incl, o); if (lane >= o) incl += t; }
    const int total = __shfl(incl, 63), end = __shfl(incl, e), off = end - __shfl(padl, e);
    if (lane == 0) { p.OFF[e * 32] = off; if (e == NE - 1) p.OFF[NE * 32] = total; }
    for (int b = off / MBLK + lane; b < end / MBLK; b += 64) p.BLKE[b * 32] = e;
    if (e == NE - 1) for (int b = total / MBLK + lane; b < NBLK; b += 64) p.BLKE[b * 32] = -1;
    int run = 0;
    for (int base = 0; base < ntok * 2; base += 512) {
        int ex[8];
#pragma unroll
        for (int q = 0; q < 8; ++q) ex[q] = p.RE[base + q * 64 + lane];
#pragma unroll
        for (int q = 0; q < 8; ++q) {
            const int i = base + q * 64 + lane; const bool m = ex[q] == e;
            const unsigned long long mask = __ballot(m);
            if (m) { const int s2 = off + run + __popcll(mask & ((1ull << lane) - 1ull)); p.SLOT_TOK[s2] = i >> 1; p.SLOT_OF[(size_t)i * 32] = s2; }
            run += __popcll(mask);
        }
    }
    for (int s2 = off + run + lane; s2 < end; s2 += 64) p.SLOT_TOK[s2] = -1;
}
__device__ __forceinline__ void ph_wl_prep(const P& p) {
    int tid = threadIdx.x; HIDE(tid);
    for (int it = blockIdx.x * 512 + tid; it < DEPTH * 4 * LW * LW; it += gridDim.x * 512) {
        const int k = it % LW, nn = (it / LW) % (4 * LW), l = it / (LW * 4 * LW);
        const int dir = nn / (2 * LW), c = (nn % (2 * LW)) >> 1, gate = nn & 1;
        float w = 0.f;
        if (k / LBW == c / LBW) w = (gate ? p.lru_w_i : p.lru_w_r)[(((size_t)(l * 2 + dir) * 4 + c / LBW) * LBW + k % LBW) * LBW + c % LBW];
        p.WlT[it] = f2bf(w);
    }
}
namespace pg8 {
struct EpiLru {
    float* LA; float* LBX;
    __device__ __forceinline__ void operator()(const f32x4 (&acc)[2][2][4][2], const Unit& u, int wr, int wc, int fr, int fq) const {
#pragma unroll
        for (int bj = 0; bj < 2; ++bj) {
            const int col = u.col0 + bj * HALF + wc * 32 + 8 * fq, dir = col / (2 * LW), c0 = (col % (2 * LW)) >> 1;
#pragma unroll
            for (int ai = 0; ai < 2; ++ai)
#pragma unroll
                for (int m = 0; m < 4; ++m) { const int r = u.row0 + ai * HALF + wr * 64 + m * 16 + fr;
                    const f32x4 v0 = acc[ai][bj][m][0], v1 = acc[ai][bj][m][1];
                    *(u32x2*)((bf16_t*)LA + ((size_t)dir * NT + r) * LW + c0) = (u32x2){cvt_pk_bf16(v0[0], v0[2]), cvt_pk_bf16(v1[0], v1[2])}; *(u32x2*)((bf16_t*)LBX + ((size_t)dir * NT + r) * LW + c0) = (u32x2){cvt_pk_bf16(v0[1], v0[3]), cvt_pk_bf16(v1[1], v1[3])}; }
        }
    }
};
}
__device__ __forceinline__ void ph_lru_gates(const P& p, int l, LAS unsigned char* lds) {
    pg8::DenseSched S; S.init(NT, 4 * LW, LW, p.WlT + (size_t)l * 4 * LW * LW, gridDim.x, blockIdx.x);
    pg8::EpiLru E{p.LA, p.LBX};
    pg8::gemm_phase(lds, p.LXRb, LW, LW, LW, S, E);
}
__device__ __forceinline__ void ph_lru_scan(const P& p, int l) {
    int tid = threadIdx.x; HIDE(tid);
    if (tid < 64) return;
    bf16_t* LHb = (bf16_t*)p.LH; bf16_t* LAb = LHb + (size_t)2 * NT * LW;
    for (int it = blockIdx.x * 448 + (tid - 64); it < NB * 2 * NCH * LW; it += gridDim.x * 448) {
        const int c = it % LW, ci = (it / LW) % NCH, dir = (it / (LW * NCH)) % 2, b = it / (LW * NCH * 2);
        const float br = p.lru_b_r[(l * 2 + dir) * LW + c], bi = p.lru_b_i[(l * 2 + dir) * LW + c], sp = -8.0f * softplusf(-p.lru_lambda[(l * 2 + dir) * LW + c]);
        float h = 0.f, A = 1.f;
        for (int i0 = 0; i0 < 64; i0 += 16) {
            float pa[16], pb[16], px[16]; size_t ixs[16];
#pragma unroll
            for (int i = 0; i < 16; ++i) { const int n = chunk_tok(b, dir, ci, i0 + i); ixs[i] = ((size_t)dir * NT + n) * LW + c; pa[i] = bf2f(((const bf16_t*)p.LA)[ixs[i]]); pb[i] = bf2f(((const bf16_t*)p.LBX)[ixs[i]]); px[i] = bf2f(p.LXRb[(size_t)n * LW + c]); }
#pragma unroll
            for (int i = 0; i < 16; ++i) {
                const float la = sigmoidf(pa[i] + br) * sp, a = fexp(la), bx = __builtin_amdgcn_sqrtf(neg_expm1f(2.0f * la)) * (sigmoidf(pb[i] + bi) * px[i]);
                h = a * h + bx; A *= a; LHb[ixs[i]] = f2bf(h); LAb[ixs[i]] = f2bf(A);
            }
        }
    }
}
__device__ __forceinline__ void ph_prep_w(const P& p, int l) {
    typedef float f32x4 __attribute__((ext_vector_type(4)));
    typedef unsigned u32x2 __attribute__((ext_vector_type(2)));
    typedef unsigned u32x4 __attribute__((ext_vector_type(4)));
    int tid = threadIdx.x; HIDE(tid);
    const int lane = tid & 63, wave = blockIdx.x * 8 + (tid >> 6), nwaves = gridDim.x * 8;
    for (int n = wave; n < NT; n += nwaves) {
        int s0, len; tok_seg(n, s0, len);
        const bf16_t* pr = p.PROJb + (size_t)n * NPJ;
        f32x4 vq[3];
#pragma unroll
        for (int which = 0; which < 3; ++which) {
            const int c0 = which * GW + lane * 4;
            const float* w = p.gdn_conv_w + (size_t)l * 4 * 3 * GW + c0;
            f32x4 acc = (f32x4){0.f, 0.f, 0.f, 0.f};
#pragma unroll
            for (int j = 0; j < 4; ++j) { const int m = n + j - 1; if (m >= s0 && m < s0 + len) acc = acc + *(const f32x4*)(w + j * 3 * GW) * ldb4(p.PROJb + (size_t)m * NPJ + c0); }
            f32x4 v; v[0] = siluf(acc[0]); v[1] = siluf(acc[1]); v[2] = siluf(acc[2]); v[3] = siluf(acc[3]);
            if (which < 2) {
                float ss = v[0] * v[0] + v[1] * v[1] + v[2] * v[2] + v[3] * v[3];
                ss += __shfl_xor(ss, 1); ss += __shfl_xor(ss, 2); ss += __shfl_xor(ss, 4); ss += __shfl_xor(ss, 8);
                v = v * (frsq(ss + EPS) * (which == 0 ? 0.125f : 1.0f));
            }
            vq[which] = v;
        }
        const int lg = lane & (2 * GH - 1);
        const float al = p.AB[(size_t)n * 32 + lg], be = p.AB[(size_t)n * 32 + 2 * GH + lg];
        const float gg = -fexp(p.gdn_a_log[l * 2 * GH + lg]) * softplusf(al + p.gdn_dt_bias[l * 2 * GH + lg]), gb = sigmoidf(be);
        f32x4 lacc;
        {
            const int c0 = lane * 4; const float* w = p.lru_conv_w + (size_t)l * 4 * LW + c0;
            f32x4 acc = *(const f32x4*)(p.lru_conv_b + l * LW + c0);
#pragma unroll
            for (int j = 0; j < 4; ++j) { const int m = n + j - 1; if (m >= s0 && m < s0 + len) acc = acc + *(const f32x4*)(w + j * LW) * ldb4(p.PROJb + (size_t)m * NPJ + O_L + c0); }
            lacc = acc;
        }
        const int b = n < NL ? n / SEQ : (n - NL) / CTX, kk = n < NL ? n % SEQ : SEQ + (n - NL) % CTX;
        const float* rt = p.ROPE + (size_t)(n < NL ? n % SEQ : 0) * 64;
        u32x4 wqk[2];
#pragma unroll
        for (int isk = 0; isk < 2; ++isk) {
            const int ls = isk ? (lane & 15) : lane, d0 = (ls & 7) * 8;
            const bf16_t* src = pr + O_A + (isk ? AW : 0) + ls * 8; const float* g = (isk ? p.attn_k_norm_g : p.attn_q_norm_g) + l * HD + d0;
            const f32x4 a0 = ldb4(src), a1 = ldb4(src + 4);
            float x[8] = {a0[0], a0[1], a0[2], a0[3], a1[0], a1[1], a1[2], a1[3]};
            float ss = 0.f;
#pragma unroll
            for (int e = 0; e < 8; ++e) ss += x[e] * x[e];
            ss += __shfl_xor(ss, 1); ss += __shfl_xor(ss, 2); ss += __shfl_xor(ss, 4);
            const float rs = frsq(ss * (1.0f / HD) + EPS);
#pragma unroll
            for (int e = 0; e < 8; ++e) x[e] = x[e] * rs * g[e];
            if (n < NL) {
                const int second = (ls >> 1) & 1, half = (ls >> 2) & 1, i0 = (ls & 1) * 8;
#pragma unroll
                for (int e = 0; e < 8; ++e) { const float other = __shfl_xor(x[e], 2), cs = rt[half * 32 + i0 + e], sn = rt[half * 32 + 16 + i0 + e];
                    x[e] = second ? other * sn + x[e] * cs : x[e] * cs - other * sn; }
            }
            const float qs = isk ? 1.0f : QSCALE;
            wqk[isk] = (u32x4){att::pk(x[0] * qs, x[1] * qs), att::pk(x[2] * qs, x[3] * qs), att::pk(x[4] * qs, x[5] * qs), att::pk(x[6] * qs, x[7] * qs)};
        }
#pragma unroll
        for (int which = 0; which < 3; ++which) *(u32x2*)((bf16_t*)p.GQKV + (size_t)n * 3 * GW + which * GW + lane * 4) = (u32x2){att::pk(vq[which][0], vq[which][1]), att::pk(vq[which][2], vq[which][3])};
        if (lane < 2 * GH) { p.GG[(size_t)n * 2 * GH + lane] = gg; p.GB[(size_t)n * 2 * GH + lane] = gb; }
        *(u32x2*)(p.LXRb + (size_t)n * LW + lane * 4) = (u32x2){att::pk(lacc[0], lacc[1]), att::pk(lacc[2], lacc[3])};
        *(u32x4*)(p.AQb + (size_t)n * AW + lane * 8) = wqk[0];
        if (lane < 16) *(u32x4*)(p.Kc + ((size_t)(b * AKH + (lane >> 3)) * KK + kk) * HD + (lane & 7) * 8) = wqk[1];
    }
    for (int it = blockIdx.x * 512 + tid; it < NB * AKH * (KK / 64) * HD * 4; it += gridDim.x * 512) {
        const int d = it % HD, qtr = (it / HD) % 4, rest = it / (HD * 4), kb = rest % (KK / 64), kvh = (rest / (KK / 64)) % AKH, b = rest / ((KK / 64) * AKH);
        const int n0 = (kb * 64 < SEQ ? b * SEQ + kb * 64 : NL + b * CTX + (kb * 64 - SEQ)) + qtr * 16;
        const bf16_t* vsrc = p.PROJb + (size_t)n0 * NPJ + O_A + AW + KVW + kvh * HD + d;
        bf16_t* vb = p.Vt + ((size_t)(b * AKH + kvh) * HD + d) * KK + kb * 64 + qtr * 16;
        unsigned w[8];
#pragma unroll
        for (int i = 0; i < 8; ++i) w[i] = (unsigned)vsrc[(size_t)(2 * i) * NPJ] | ((unsigned)vsrc[(size_t)(2 * i + 1) * NPJ] << 16);
        *(u32x4*)vb = (u32x4){w[0], w[1], w[2], w[3]}; *(u32x4*)(vb + 8) = (u32x4){w[4], w[5], w[6], w[7]};
    }
}
__device__ __forceinline__ void ph_readout_w(const P& p, int l, int ntok) {
    typedef float f32x4 __attribute__((ext_vector_type(4)));
    typedef unsigned u32x2 __attribute__((ext_vector_type(2)));
    int tid = threadIdx.x; HIDE(tid);
    const int lane = tid & 63, wave = blockIdx.x * 8 + (tid >> 6), nwaves = gridDim.x * 8, c0 = lane * 4;
    for (int n = wave; n < ntok; n += nwaves) {
        const bf16_t* pr = p.PROJb + (size_t)n * NPJ;
        u32x2 wg;
        {   const f32x4 v = *(const f32x4*)(p.GO + (size_t)n * GW + c0) + *(const f32x4*)(p.GO + ((size_t)NT + n) * GW + c0);
            float ss = v[0] * v[0] + v[1] * v[1] + v[2] * v[2] + v[3] * v[3];
            ss += __shfl_xor(ss, 1); ss += __shfl_xor(ss, 2); ss += __shfl_xor(ss, 4); ss += __shfl_xor(ss, 8);
            const float rs = frsq(ss * (1.0f / HD) + EPS);
            const f32x4 g = *(const f32x4*)(p.gdn_norm_g + l * HD + (c0 & (HD - 1))), gate = ldb4(pr + 3 * GW + c0);
            wg = (u32x2){att::pk(v[0] * rs * g[0] * siluf(gate[0]), v[1] * rs * g[1] * siluf(gate[1])), att::pk(v[2] * rs * g[2] * siluf(gate[2]), v[3] * rs * g[3] * siluf(gate[3]))};
        }
        {   const int bb = n < NL ? n / SEQ : (n - NL) / CTX;
            f32x4 hs = (f32x4){0.f, 0.f, 0.f, 0.f};
#pragma unroll
            for (int d = 0; d < 2; ++d) { const size_t ix = ((size_t)d * NT + n) * LW + c0;
                hs = hs + ldb4((const bf16_t*)p.LH + ix) + ldb4((const bf16_t*)p.LH + (size_t)2 * NT * LW + ix) * *(const f32x4*)(p.CARRY + ((size_t)(bb * 2 + d) * NCH + tok_chunk(n, d)) * LW + c0); }
            const f32x4 y = ldb4(pr + O_L + LW + c0);
            *(u32x2*)(p.MIXb + (size_t)n * D + c0) = wg;
            *(u32x2*)(p.MIXb + (size_t)n * D + GW + c0) = (u32x2){att::pk(hs[0] * gelu_tanhf(y[0]), hs[1] * gelu_tanhf(y[1])), att::pk(hs[2] * gelu_tanhf(y[2]), hs[3] * gelu_tanhf(y[3]))};
        }
    }
}
#endif


#ifdef HOST_EMU
#define WQ(minblk, nb)
#define HOSTB true
#define GTID0 ((int)gtid0)
#define LOADP
typedef int LdsPtr;
#define DO_WPREP
#define DO_INIT ph_init(p, gtid, gsize)
#define DO_INPROJ ph_inproj(p, l, gtid, gsize)
#define DO_OUTPROJ ph_outproj(p, l, ntok, gtid, gsize)
#define DO_MOE1 ph_moe1(p, l, gtid, gsize)
#define DO_MOE2 ph_moe2(p, l, gtid, gsize)
#define DO_ATTN ph_attn(p, l, ntok, gtid, gsize)
#define DO_GDN_A
#define DO_GDN_B ph_gdn_naive(p, l, gtid, gsize)
#define DO_MOD ph_mod(p, gtid, gsize)
#define DO_COMBINE_OR_MODRED if (l > 0) ph_combine(p, l - 1, ntok_prev, gtid, gsize)
#define DO_NORM1 ph_norm1(p, l, gtid, gsize)
#define DO_PREP ph_prep(p, l, gtid, gsize)
#define DO_LRU_CARRY ph_lru_carry(p, gtid, gsize)
#define DO_READOUT ph_readout(p, l, ntok, gtid, gsize)
#define DO_LRU_GATES
#define DO_LRU_LOCAL ph_lru_local(p, l, gtid, gsize)
#define DO_ROUTE ph_route(p, l, ntok, gtid, gsize)
#define DO_ROUTE2
#define DO_ROUTE3
#define DO_OFFSETS ph_offsets(p, gtid, gsize)
#define DO_SLOTS ph_slots(p, ntok, gtid, gsize)
#define DO_FINAL_COMBINE ph_combine(p, DEPTH - 1, NL, gtid, gsize)
#define DO_FINAL ph_final(p, gtid, gsize)
#else
#define HOSTB false
#define GTID0 ((int)(blockIdx.x * 512 + threadIdx.x))
typedef LAS unsigned char* LdsPtr;
typedef const __attribute__((address_space(4))) P* KernArgP;
#define LOADP P p_; { KernArgP k_ = (KernArgP)__builtin_amdgcn_kernarg_segment_ptr(); asm volatile("" : "+s"(k_)); const __attribute__((address_space(4))) unsigned long long* q_ = (const __attribute__((address_space(4))) unsigned long long*)k_; void** d_ = (void**)&p_; _Pragma("unroll") for (int i_ = 0; i_ < (int)(sizeof(P) / 8); ++i_) d_[i_] = (void*)(__attribute__((address_space(1))) void*)q_[i_]; }     const P& p = p_;
#ifndef MFMA_DENSE
#define MFMA_DENSE 1
#endif
#ifndef MFMA_MOE
#define MFMA_MOE 1
#endif
#define DO_INIT
#define DO_WPREP ph_wprep(p, lds); ph_wr_prep(p); ph_wl_prep(p); wq_pull(p, 0, -1, lds)
#define WQ(minblk, nb) do { if ((int)blockIdx.x >= (minblk)) wq_pull(p, l + 1, (nb), lds); } while (0)
#define DO_MOD ph_mod_part(p, lds)
#define DO_COMBINE_OR_MODRED if (l == 0) ph_mod_reduce(p)
#define DO_NORM1 ph_norm1_aux(p, gtid, gsize); ph_rownorm(p, l, l - 1, NT, NT)
#define DO_PREP ph_prep_w(p, l)
#define DO_LRU_CARRY ph_lru_carry_w(p, gtid - 128 * 512 < 0 ? gsize : gtid - 128 * 512, gsize)
#define DO_READOUT ph_readout_w(p, l, ntok)
#define DO_LRU_GATES ph_lru_gates(p, l, lds)
#define DO_LRU_LOCAL ph_lru_scan(p, l)
#define DO_ROUTE ph_norm2_w(p, l, ntok)
#define DO_ROUTE2 ph_rgemm(p, l, ntok, lds)
#define DO_ROUTE3 ph_topk(p, l, ntok, lds)
#define DO_OFFSETS
#define DO_SLOTS ph_slots_off_w(p, ntok)
#define DO_FINAL_COMBINE
#define DO_FINAL ph_rownorm(p, DEPTH, DEPTH - 1, NL, NL)
#ifndef MFMA_GDN
#define MFMA_GDN 1
#endif
#if MFMA_GDN
#define DO_GDN_A ph_gdn_a(p, l, lds)
#define DO_GDN_B ph_gdn_b(p, l, lds)
#else
#define DO_GDN_A
#define DO_GDN_B ph_gdn_naive(p, l, gtid, gsize)
#endif
#ifndef MFMA_ATTN
#define MFMA_ATTN 1
#endif
#if MFMA_ATTN
#define DO_ATTN ph_attn_mfma(p, l, ntok == NT, lds)
#else
#define DO_ATTN ph_attn(p, l, ntok, gtid, gsize)
#endif
#if MFMA_DENSE
#define DO_INPROJ ph_inproj_mfma(p, l, lds)
#define DO_OUTPROJ ph_outproj_mfma(p, l, ntok, lds)
#else
#define DO_INPROJ ph_inproj(p, l, gtid, gsize)
#define DO_OUTPROJ ph_outproj(p, l, ntok, gtid, gsize)
#endif
#if MFMA_MOE
#define DO_MOE1 ph_moe1_mfma(p, l, lds)
#define DO_MOE2 ph_moe2_mfma(p, l, lds)
#else
#define DO_MOE1 ph_moe1(p, l, gtid, gsize)
#define DO_MOE2 ph_moe2(p, l, gtid, gsize)
#endif
#endif
template <bool ALL, class BarFn>
DEV void run_phases(const P& p, int ph_lo, int ph_hi, long gtid0, long gsize, LdsPtr lds, BarFn bar) {
    int ph = 0;
#define PHASE(body) do { if (ALL || (ph >= ph_lo && ph < ph_hi)) { int gt_ = GTID0; HIDE(gt_); const long gtid = gt_; { LOADP; body; } if (ALL || ph + 1 < ph_hi) bar(); } if (!ALL) ++ph; } while (0)
#define PHASE_IF(cond, body) do { if (cond) PHASE(body); } while (0)
    PHASE({ DO_MOD; DO_INIT; ph_rope(p, gtid, gsize); DO_WPREP; });
#define LAYER(L_) if (L_ < DEPTH) { constexpr int l = L_; \
        const int ntok = l < DEPTH - 1 ? NT : NL;         \
        const int ntok_prev = l - 1 < DEPTH - 1 ? NT : NL; \
        PHASE_IF(HOSTB || l == 0, { DO_COMBINE_OR_MODRED; }); \
        PHASE({ DO_NORM1; }); \
        PHASE({ DO_INPROJ; }); \
        PHASE({ DO_PREP; }); \
        PHASE_IF(!HOSTB, { DO_LRU_GATES; }); \
        PHASE({ DO_GDN_A; DO_LRU_LOCAL; }); \
        PHASE({ DO_GDN_B; DO_LRU_CARRY; DO_ATTN; }); \
        PHASE({ DO_READOUT; }); \
        PHASE({ DO_OUTPROJ; WQ(32, 5); }); \
        PHASE({ DO_ROUTE; }); \
        PHASE_IF(!HOSTB, { DO_ROUTE2; WQ(216, 3); }); \
        PHASE_IF(!HOSTB, { DO_ROUTE3; WQ(0, 3); }); \
        PHASE_IF(HOSTB, { DO_OFFSETS; }); \
        PHASE({ DO_SLOTS; WQ(8, -1); }); \
        PHASE({ DO_MOE1; }); \
        PHASE({ DO_MOE2; }); \
    }
    LAYER(0) LAYER(1) LAYER(2) LAYER(3)
#undef LAYER
    static_assert(DEPTH <= 4, "LAYER instances");
    PHASE_IF(HOSTB, { DO_FINAL_COMBINE; });
    { int gt_ = GTID0; HIDE(gt_); const long gtid = gt_; if (ALL || (ph >= ph_lo && ph < ph_hi)) { LOADP; DO_FINAL; } }
#undef PHASE
}
constexpr int TOTAL_PHASES = 1 + 13 * DEPTH + 2;

struct Carver { char* base; size_t off; template <class T> T* take(size_t n) { off = (off + 255) & ~(size_t)255; T* r = (T*)(base + off); off += n * sizeof(T); return r; } };
static inline size_t carve(P& p, void* ws) {
    Carver c{(char*)ws, 0};
    p.bar = c.take<unsigned>(4096);
    p.CNT = c.take<int>(NE); p.OFF = c.take<int>((NE + 1) * 32); p.BLKE = c.take<int>(NBLK * 32);
    p.X = c.take<float>((size_t)NT * D); p.ROPE = c.take<float>((size_t)SEQ * 64); p.PART = c.take<float>((size_t)8 * DEPTH * (NB + 1) * 6 * D); p.CARRY = c.take<float>((size_t)NB * 2 * NCH * LW); p.MOD = c.take<float>((size_t)DEPTH * (NB + 1) * 6 * D); p.HNb = c.take<bf16_t>((size_t)NT * D);
#ifdef HOST_EMU
    p.PROJ = c.take<float>((size_t)NT * PJS); p.AQ = c.take<float>((size_t)NT * AW); p.AK = c.take<float>((size_t)NT * KVW); p.Y = c.take<float>((size_t)NSLOT * D);
#endif
    p.GQKV = c.take<float>((size_t)NT * 3 * GW); p.GG = c.take<float>((size_t)NT * 2 * GH); p.GB = c.take<float>((size_t)NT * 2 * GH);
    p.GO = c.take<float>((size_t)2 * NT * GW); p.LXR = c.take<float>((size_t)NT * LW); p.LA = c.take<float>((size_t)2 * NT * LW);
    p.LH = c.take<float>((size_t)2 * NT * LW); p.MIXb = c.take<bf16_t>((size_t)NT * D);
    p.H2b = c.take<bf16_t>((size_t)NT * H2S); p.LOGIT = c.take<float>((size_t)3 * NT * 128); p.RG = c.take<float>((size_t)NT * 2); p.RE = c.take<int>((size_t)NT * 2);
    p.SLOT_TOK = c.take<int>(NSLOT); p.SLOT_OF = c.take<int>((size_t)NT * 2 * 32); p.ACTb = c.take<bf16_t>((size_t)NSLOT * HID);
    p.LXRb = c.take<bf16_t>((size_t)NT * LW); p.LBX = c.take<float>((size_t)2 * NT * LW);
    p.AQb = c.take<bf16_t>((size_t)NT * AW); p.Kc = c.take<bf16_t>((size_t)NB * AKH * KK * HD); p.Vt = c.take<bf16_t>((size_t)NB * AKH * HD * KK);
#ifndef HOST_EMU
    p.Yb = c.take<bf16_t>((size_t)NSLOT * D);
    p.PROJb = c.take<bf16_t>((size_t)NT * NPJ); p.AB = c.take<float>((size_t)NT * 32);
    { const size_t ncp = (size_t)NB * GH * 2 * ((CTX + SEQ) / 64); p.GWN = c.take<bf16_t>(ncp * 4096); p.GQG = c.take<bf16_t>(ncp * 4096); p.GQK = c.take<bf16_t>(ncp * 4096); p.GKT = c.take<bf16_t>(ncp * 4096); p.GU = c.take<float>(ncp * 4096); p.GEL = c.take<float>(ncp * 32); }
    p.WinT = c.take<bf16_t>((size_t)DEPTH * NPJ * D); p.WoutT = c.take<bf16_t>((size_t)DEPTH * D * D);
    p.WrT = c.take<bf16_t>((size_t)DEPTH * 256 * H2S); p.WlT = c.take<bf16_t>((size_t)DEPTH * 4 * LW * LW); p.W13T = c.take<bf16_t>((size_t)DEPTH * NE * 2 * HID * D); p.W2T = c.take<bf16_t>((size_t)DEPTH * NE * D * HID);
#endif
    return c.off;
}
static inline void set_inputs(P& p, void* const* d_in, void* d_out) {
    const float** f = (const float**)&p.x;
    for (int i = 0; i < 31; ++i) f[i] = (const float*)d_in[i];
    p.out = (float*)d_out;
}

#ifndef HOST_EMU
#define XB_TMO      128
#define XB_XCNT(j)  (256  + 64 * (j))
#define XB_XSUB(j)  (1280 + 64 * (j))
#define XB_XGEN(j)  (2304 + 64 * (j))
#define XB_TOP      3328
#define XB_TOPGEN   3392
#define XCD_BAR_WORDS 3456
#define XB_SPIN_CAP (1u << 18)
__device__ __forceinline__ unsigned xb_ld(unsigned* p)              { return __hip_atomic_load(p, __ATOMIC_RELAXED, __HIP_MEMORY_SCOPE_AGENT); }
__device__ __forceinline__ unsigned xb_add(unsigned* p, unsigned v) { return __hip_atomic_fetch_add(p, v, __ATOMIC_RELAXED, __HIP_MEMORY_SCOPE_AGENT); }
__device__ __forceinline__ unsigned xb_xcc_id() { return (unsigned)__builtin_amdgcn_s_getreg((3 << 11) | 20) & 0xFu; }
#define XB_SPIN(cond, bar) do { unsigned _sp = 0; while (cond) { __builtin_amdgcn_s_sleep(1); \
    if ((++_sp & 255u) == 0u) { if (xb_ld(&(bar)[XB_TMO])) break; if (_sp > XB_SPIN_CAP) { atomicAdd(&(bar)[XB_TMO], 1u); break; } } } } while (0)
struct XcdBarrier { unsigned* bar; unsigned x; volatile LAS unsigned* st; };
__device__ __forceinline__ XcdBarrier xcd_barrier_post(unsigned* bar, volatile LAS unsigned* st) {
    XcdBarrier b; b.bar = bar; b.x = xb_xcc_id(); b.st = st;
    if (threadIdx.x == 0) (void)xb_add(&bar[XB_XCNT(b.x)], 1u);
    return b;
}
__device__ __forceinline__ void xcd_barrier_complete(unsigned* bar, unsigned x, unsigned& nloc, unsigned& nx) {
    const unsigned G = gridDim.x * gridDim.y * gridDim.z;
    unsigned sum, cnt, mine, sp = 0u;
    for (;;) {
        sum = 0u; cnt = 0u; mine = 0u;
#pragma unroll
        for (unsigned j = 0; j < 16; ++j) { const unsigned c = xb_ld(&bar[XB_XCNT(j)]); sum += c; cnt += (c > 0u) ? 1u : 0u; mine = (j == x) ? c : mine; }
        if (sum == G) break;
        __builtin_amdgcn_s_sleep(1);
        if ((++sp & 255u) == 0u) { if (xb_ld(&bar[XB_TMO])) break; if (sp > XB_SPIN_CAP) { atomicAdd(&bar[XB_TMO], 1u); break; } }
    }
    nloc = mine > 0u ? mine : 1u; nx = cnt > 0u ? cnt : 1u;
}
__device__ __forceinline__ void xcd_barrier(const XcdBarrier& b) {
    asm volatile("s_waitcnt vmcnt(0)" ::: "memory");
    __syncthreads();
    if (threadIdx.x == 0) {
        unsigned long long bq_ = (unsigned long long)b.bar; asm volatile("" : "+s"(bq_)); unsigned* bar = (unsigned*)(__attribute__((address_space(1))) unsigned*)bq_;
        __builtin_amdgcn_s_waitcnt(0);
        unsigned nloc = b.st[0], nx = b.st[1];
        if (nloc == 0u) { xcd_barrier_complete(bar, b.x, nloc, nx); b.st[0] = nloc; b.st[1] = nx; }
        const unsigned old = xb_add(&bar[XB_XSUB(b.x)], 1u);
        const unsigned gen = old / nloc;
        if (old + 1u == (gen + 1u) * nloc) {
            __builtin_amdgcn_fence(__ATOMIC_RELEASE, "agent");
            asm volatile("s_waitcnt vmcnt(0)" ::: "memory");
            const unsigned og = xb_add(&bar[XB_TOP], 1u);
            const unsigned tg = og / nx;
            if (og + 1u == (tg + 1u) * nx) xb_add(&bar[XB_TOPGEN], 1u);
            else XB_SPIN(xb_ld(&bar[XB_TOPGEN]) == tg, bar);
            __builtin_amdgcn_fence(__ATOMIC_ACQUIRE, "agent");
            xb_add(&bar[XB_XGEN(b.x)], 1u);
            asm volatile("s_waitcnt vmcnt(0)" ::: "memory");
        } else {
            XB_SPIN(xb_ld(&bar[XB_XGEN(b.x)]) == gen, bar);
            __builtin_amdgcn_fence(__ATOMIC_ACQUIRE, "agent");
            asm volatile("s_waitcnt vmcnt(0)" ::: "memory");
        }
    }
    __syncthreads();
}

constexpr int NTHREADS = 512;
constexpr int LDS_BYTES = 147456, LDS_MISC = 131072;
__global__ void __launch_bounds__(NTHREADS, 2) mega(P p, int ph_lo, int ph_hi) {
    extern __shared__ __attribute__((aligned(16))) unsigned char lds_raw[];
    LAS unsigned char* lds = (LAS unsigned char*)lds_raw;
    volatile LAS unsigned* misc = (volatile LAS unsigned*)(lds + LDS_MISC);
    if (threadIdx.x < 4) misc[threadIdx.x] = 0u;
    __syncthreads();
    if (threadIdx.x == 0) misc[2] = xb_xcc_id();
    (void)xcd_barrier_post(p.bar, misc);
    __syncthreads();
    const long gtid = 0, gsize = (long)gridDim.x * NTHREADS;
    auto bar = []() { LOADP; LAS unsigned char* l_ = (LAS unsigned char*)0; volatile LAS unsigned* m_ = (volatile LAS unsigned*)(l_ + LDS_MISC); XcdBarrier b; b.bar = p.bar; b.x = m_[2]; b.st = m_; xcd_barrier(b); };
#ifdef MK_MULTI
    run_phases<false>(p, ph_lo, ph_hi, gtid, gsize, lds, bar);
#else
    run_phases<true>(p, ph_lo, ph_hi, gtid, gsize, lds, bar);
#endif
}

extern "C" void kernel_launch(void* const* d_in, const int* in_sizes, int n_in, void* d_out, int out_size, void* d_ws, size_t ws_size, hipStream_t stream) {
    P p{}; set_inputs(p, d_in, d_out);
    if (carve(p, d_ws) > ws_size) { fprintf(stderr, "kernel_launch: workspace too small\n"); return; }
    static int grid = 0;
    if (!grid) {
        int dev = 0, cus = 0;
        (void)hipGetDevice(&dev); (void)hipDeviceGetAttribute(&cus, hipDeviceAttributeMultiprocessorCount, dev);
        (void)hipFuncSetAttribute((const void*)mega, hipFuncAttributeMaxDynamicSharedMemorySize, LDS_BYTES);
        grid = cus > 0 ? cus : 256;
    }
    (void)hipMemsetAsync(p.bar, 0, 4096 * sizeof(unsigned), stream);
#ifdef MK_MULTI
    for (int ph = 0; ph < TOTAL_PHASES; ++ph) mega<<<grid, NTHREADS, LDS_BYTES, stream>>>(p, ph, ph + 1);
#else
    mega<<<grid, NTHREADS, LDS_BYTES, stream>>>(p, 0, TOTAL_PHASES);
#endif
}
#endif
```
